# Optimizing an MI355X kernel written in HIP

```python
import math
import jax
import jax.numpy as jnp
from jax import lax
import numpy as np

D_MODEL = 1024
BATCH = 8
SEQ = 8192
DEPTH = 2
DEC_BATCH = 16
DEC_SEQ = 2048
PAST_LEN = 128

HEAD_DIM = 64
GRID_W = 64
NA_HEADS = 8
NA_WIN_ROWS = 8
NA_WIN_COLS = 16
NA_WIDTH = NA_HEADS * HEAD_DIM
HY_WIDTH = D_MODEL // 2
HY_ORDER = 2
HY_DIRS = 2
HY_SHORT_CONV = 3
HY_POS_BANDS = 16
HY_EMB_DIM = 1 + 2 * HY_POS_BANDS
HY_FILTER_HIDDEN = 64
HY_FAST_DECAY_PCT = 0.3
HY_SLOW_DECAY_PCT = 1.5
HY_DECAY_TARGET = 1e-2
SWA_HEADS = 8
SWA_KV_HEADS = 2
SWA_WIDTH = SWA_HEADS * HEAD_DIM
SWA_KV_WIDTH = SWA_KV_HEADS * HEAD_DIM
SWA_WINDOW = 128
SWA_BLOCK = 128
N_BRANCH = 3
D_FF = 4 * D_MODEL
OFF_HY = 3 * NA_WIDTH
OFF_SWA = OFF_HY + 3 * HY_WIDTH
OFF_GATE = OFF_SWA + SWA_WIDTH + 2 * SWA_KV_WIDTH
D_IN = OFF_GATE + N_BRANCH * D_MODEL
DEEPNORM_ALPHA = (2 * DEPTH) ** 0.25
DEEPNORM_BETA = (8 * DEPTH) ** -0.25
LN_EPS = 1e-5
NEG_BIG = -1e30

kernel_name = "hybrid_bidir_encoder_two_groups"


def _layernorm(x, g, b):
    xf = x.astype(jnp.float32)
    mu = jnp.mean(xf, axis=-1, keepdims=True)
    var = jnp.mean(jnp.square(xf - mu), axis=-1, keepdims=True)
    return ((xf - mu) * lax.rsqrt(var + LN_EPS) * g + b).astype(x.dtype)


def _neighbourhood_attention(q, k, v, rpb):
    b_sz, seq_len, heads, dh = q.shape
    rows = seq_len // GRID_W
    kr = min(NA_WIN_ROWS, rows)
    kc = NA_WIN_COLS
    qg = q.reshape(b_sz * rows, GRID_W, heads, dh)
    kg = k.reshape(b_sz, rows, GRID_W, heads, dh)
    vg = v.reshape(b_sz, rows, GRID_W, heads, dh)
    cols = jnp.arange(GRID_W)
    col_start = jnp.clip(cols - kc // 2, 0, GRID_W - kc)
    col_idx = col_start[:, None] + jnp.arange(kc)[None, :]
    rpb_cols = rpb[:, :, col_idx - cols[:, None] + (NA_WIN_COLS - 1)]
    scale = dh ** -0.5

    def row_block(idx):
        bi = idx // rows
        r = idx % rows
        rs = jnp.clip(r - kr // 2, 0, rows - kr)
        q_r = qg[idx]
        k_r = lax.dynamic_slice(kg, (bi, rs, 0, 0, 0), (1, kr, GRID_W, heads, dh))[0]
        v_r = lax.dynamic_slice(vg, (bi, rs, 0, 0, 0), (1, kr, GRID_W, heads, dh))[0]
        k_n = k_r[:, col_idx]
        v_n = v_r[:, col_idx]
        bias = jnp.transpose(rpb_cols[:, rs + jnp.arange(kr) - r + (NA_WIN_ROWS - 1)], (0, 2, 1, 3))
        s = jnp.einsum('whd,rwkhd->hwrk', q_r, k_n, preferred_element_type=jnp.float32) * scale + bias
        p = jax.nn.softmax(s, axis=(-2, -1))
        return jnp.einsum('hwrk,rwkhd->whd', p.astype(v.dtype), v_n)

    out = lax.map(row_block, jnp.arange(b_sz * rows))
    return out.reshape(b_sz, seq_len, heads * dh)


def _hyena_filters(seq_len, w1, b1, w2, b2, freq, w3):
    f32 = jnp.float32
    t = jnp.linspace(0.0, 1.0, seq_len, dtype=f32)[:, None]
    w = 2.0 * math.pi * jnp.arange(seq_len, dtype=f32) / seq_len
    bands = jnp.linspace(1e-4, HY_POS_BANDS - 1, HY_POS_BANDS, dtype=f32)
    ang = w[:, None] * bands[None, :]
    z = jnp.concatenate([t, jnp.cos(ang), -jnp.sin(ang)], axis=-1)
    fr = freq.astype(f32)
    h = jnp.sin(fr * (z @ w1.astype(f32) + b1.astype(f32)))
    h = jnp.sin(fr * (h @ w2.astype(f32) + b2.astype(f32)))
    h = h @ w3.astype(f32)
    min_decay = math.log(HY_DECAY_TARGET) / HY_SLOW_DECAY_PCT
    max_decay = math.log(HY_DECAY_TARGET) / HY_FAST_DECAY_PCT
    deltas = jnp.linspace(min_decay, max_decay, HY_WIDTH, dtype=f32)
    window = jnp.exp(-t * jnp.abs(deltas)[None, :])
    return h.reshape(seq_len, HY_ORDER, HY_DIRS, HY_WIDTH) * window[:, None, None, :]


def _bidir_fftconv(u, h_fwd, h_bwd):
    seq_len, ch = h_fwd.shape
    n = 2 * seq_len
    kern = jnp.concatenate([h_fwd, jnp.zeros((1, ch), jnp.float32), h_bwd[:0:-1]], axis=0)
    kf = jnp.fft.rfft(kern, n=n, axis=0)
    uf = jnp.fft.rfft(u.astype(jnp.float32), n=n, axis=1)
    y = jnp.fft.irfft(uf * kf[None], n=n, axis=1)[:, :seq_len]
    return y.astype(u.dtype)


def _hyena(proj, conv_w, conv_b, filters, bias):
    seq_len = proj.shape[1]
    half = HY_SHORT_CONV // 2
    xp = jnp.pad(proj, ((0, 0), (half, half), (0, 0)))
    u = sum(xp[:, j:j + seq_len] * conv_w[j] for j in range(HY_SHORT_CONV)) + conv_b
    v, x1, x2 = jnp.split(u, 3, axis=-1)
    z = v
    for n, gate in enumerate((x1, x2)):
        z = gate * (_bidir_fftconv(z, filters[:, n, 0], filters[:, n, 1]) + bias[n] * z)
    return z


def _window_gqa(q, k, v, sink):
    b_sz, seq_len, hq, dh = q.shape
    hkv = k.shape[2]
    grp = hq // hkv
    nb = seq_len // SWA_BLOCK
    span = SWA_BLOCK + 2 * SWA_WINDOW
    pad = ((0, 0), (SWA_WINDOW, SWA_WINDOW), (0, 0), (0, 0))
    kp = jnp.pad(k, pad)
    vp = jnp.pad(v, pad)
    slopes = 2.0 ** (-8.0 * (jnp.arange(hq, dtype=jnp.float32) + 1.0) / hq)
    q_off = jnp.arange(SWA_BLOCK)[:, None]
    k_off = jnp.arange(span) - SWA_WINDOW
    rel = jnp.abs(k_off[None, :] - q_off)
    band = rel <= SWA_WINDOW
    alibi = (-slopes[:, None, None] * rel.astype(jnp.float32)).reshape(hkv, grp, SWA_BLOCK, span)
    sink_l = sink.astype(jnp.float32).reshape(hkv, grp)[None, :, :, None, None]
    scale = dh ** -0.5

    def block(i):
        start = i * SWA_BLOCK
        q_b = lax.dynamic_slice_in_dim(q, start, SWA_BLOCK, axis=1).reshape(b_sz, SWA_BLOCK, hkv, grp, dh)
        k_b = lax.dynamic_slice_in_dim(kp, start, span, axis=1)
        v_b = lax.dynamic_slice_in_dim(vp, start, span, axis=1)
        key_pos = start + k_off
        valid = band & ((key_pos >= 0) & (key_pos < seq_len))[None, :]
        s = jnp.einsum('bqgjd,bkgd->bgjqk', q_b, k_b, preferred_element_type=jnp.float32) * scale + alibi
        s = jnp.where(valid, s, NEG_BIG)
        m = jnp.maximum(jnp.max(s, axis=-1, keepdims=True), sink_l)
        p = jnp.exp(s - m)
        denom = jnp.sum(p, axis=-1, keepdims=True) + jnp.exp(sink_l - m)
        o = jnp.einsum('bgjqk,bkgd->bqgjd', (p / denom).astype(v.dtype), v_b)
        return o.reshape(b_sz, SWA_BLOCK, hq * dh)

    out = lax.map(block, jnp.arange(nb))
    return jnp.transpose(out, (1, 0, 2, 3)).reshape(b_sz, seq_len, hq * dh)


def _encoder_block(x, w_in, b_in, hy_conv_w, hy_conv_b, hy_filt_w1, hy_filt_b1, hy_filt_w2, hy_filt_b2,
                   hy_filt_freq, hy_filt_w3, hy_bias, na_rpb, swa_sink, w_branch_a, w_branch_b, w_branch_c,
                   w_out, ln1_g, ln1_b, w_up, b_up, w_down, b_down, ln2_g, ln2_b):
    b_sz, seq_len, _ = x.shape
    h = jnp.einsum('bld,de->ble', x, w_in) + b_in
    splits = [NA_WIDTH, 2 * NA_WIDTH, OFF_HY, OFF_SWA, OFF_SWA + SWA_WIDTH,
              OFF_SWA + SWA_WIDTH + SWA_KV_WIDTH, OFF_GATE]
    na_q, na_k, na_v, hy_in, sw_q, sw_k, sw_v, gates = jnp.split(h, splits, axis=-1)
    a = _neighbourhood_attention(na_q.reshape(b_sz, seq_len, NA_HEADS, HEAD_DIM),
                                 na_k.reshape(b_sz, seq_len, NA_HEADS, HEAD_DIM),
                                 na_v.reshape(b_sz, seq_len, NA_HEADS, HEAD_DIM), na_rpb)
    filters = _hyena_filters(seq_len, hy_filt_w1, hy_filt_b1, hy_filt_w2, hy_filt_b2, hy_filt_freq, hy_filt_w3)
    hb = _hyena(hy_in, hy_conv_w, hy_conv_b, filters, hy_bias)
    c = _window_gqa(sw_q.reshape(b_sz, seq_len, SWA_HEADS, HEAD_DIM),
                    sw_k.reshape(b_sz, seq_len, SWA_KV_HEADS, HEAD_DIM),
                    sw_v.reshape(b_sz, seq_len, SWA_KV_HEADS, HEAD_DIM), swa_sink)
    g = jax.nn.sigmoid(gates.astype(jnp.float32)).astype(x.dtype).reshape(b_sz, seq_len, N_BRANCH, D_MODEL)
    merged = (g[:, :, 0] * (a @ w_branch_a) + g[:, :, 1] * (hb @ w_branch_b) + g[:, :, 2] * (c @ w_branch_c))
    mix = merged @ w_out
    x = _layernorm(DEEPNORM_ALPHA * x + mix, ln1_g, ln1_b)
    ff = jnp.square(jax.nn.relu(x @ w_up + b_up)) @ w_down + b_down
    return _layernorm(DEEPNORM_ALPHA * x + ff, ln2_g, ln2_b)


def setup_inputs(seed: int = 0) -> dict:
    key = jax.random.key(seed)
    ks = jax.random.split(key, 32)
    f32 = jnp.float32

    def nrm(k, shape, scale):
        return jax.random.normal(k, shape, f32) * scale

    return {
        'x_prompt': nrm(ks[0], (BATCH, SEQ, D_MODEL), 1.0),
        'x_sample': nrm(ks[1], (DEC_BATCH, DEC_SEQ, D_MODEL), 1.0),
        'w_in': nrm(ks[2], (DEPTH, D_MODEL, D_IN), D_MODEL ** -0.5),
        'b_in': nrm(ks[3], (DEPTH, D_IN), 0.02),
        'hy_conv_w': nrm(ks[4], (DEPTH, HY_SHORT_CONV, 3 * HY_WIDTH), HY_SHORT_CONV ** -0.5),
        'hy_conv_b': nrm(ks[5], (DEPTH, 3 * HY_WIDTH), 0.02),
        'hy_filt_w1': nrm(ks[6], (DEPTH, HY_EMB_DIM, HY_FILTER_HIDDEN), HY_EMB_DIM ** -0.5),
        'hy_filt_b1': nrm(ks[7], (DEPTH, HY_FILTER_HIDDEN), 0.02),
        'hy_filt_w2': nrm(ks[8], (DEPTH, HY_FILTER_HIDDEN, HY_FILTER_HIDDEN), HY_FILTER_HIDDEN ** -0.5),
        'hy_filt_b2': nrm(ks[9], (DEPTH, HY_FILTER_HIDDEN), 0.02),
        'hy_filt_freq': 1.0 + nrm(ks[10], (DEPTH, HY_FILTER_HIDDEN), 0.01),
        'hy_filt_w3': nrm(ks[11], (DEPTH, HY_FILTER_HIDDEN, HY_ORDER * HY_DIRS * HY_WIDTH), 0.08 * HY_FILTER_HIDDEN ** -0.5),
        'hy_bias': nrm(ks[12], (DEPTH, HY_ORDER, HY_WIDTH), 0.5),
        'na_rpb': nrm(ks[13], (DEPTH, NA_HEADS, 2 * NA_WIN_ROWS - 1, 2 * NA_WIN_COLS - 1), 0.02),
        'swa_sink': nrm(ks[14], (DEPTH, SWA_HEADS), 0.5),
        'w_branch_a': nrm(ks[15], (DEPTH, NA_WIDTH, D_MODEL), DEEPNORM_BETA * NA_WIDTH ** -0.5),
        'w_branch_b': nrm(ks[16], (DEPTH, HY_WIDTH, D_MODEL), DEEPNORM_BETA * HY_WIDTH ** -0.5),
        'w_branch_c': nrm(ks[17], (DEPTH, SWA_WIDTH, D_MODEL), DEEPNORM_BETA * SWA_WIDTH ** -0.5),
        'w_out': nrm(ks[18], (DEPTH, D_MODEL, D_MODEL), DEEPNORM_BETA * D_MODEL ** -0.5),
        'ln1_g': 1.0 + nrm(ks[19], (DEPTH, D_MODEL), 0.02),
        'ln1_b': nrm(ks[20], (DEPTH, D_MODEL), 0.02),
        'w_up': nrm(ks[21], (DEPTH, D_MODEL, D_FF), D_MODEL ** -0.5),
        'b_up': nrm(ks[22], (DEPTH, D_FF), 0.02),
        'w_down': nrm(ks[23], (DEPTH, D_FF, D_MODEL), DEEPNORM_BETA * D_FF ** -0.5),
        'b_down': nrm(ks[24], (DEPTH, D_MODEL), 0.02),
        'ln2_g': 1.0 + nrm(ks[25], (DEPTH, D_MODEL), 0.02),
        'ln2_b': nrm(ks[26], (DEPTH, D_MODEL), 0.02),
    }


def reference(x_prompt, x_sample, w_in, b_in, hy_conv_w, hy_conv_b, hy_filt_w1, hy_filt_b1, hy_filt_w2,
              hy_filt_b2, hy_filt_freq, hy_filt_w3, hy_bias, na_rpb, swa_sink, w_branch_a, w_branch_b,
              w_branch_c, w_out, ln1_g, ln1_b, w_up, b_up, w_down, b_down, ln2_g, ln2_b):
    y_prompt = x_prompt
    y_sample = x_sample
    for l in range(DEPTH):
        layer = (w_in[l], b_in[l], hy_conv_w[l], hy_conv_b[l], hy_filt_w1[l], hy_filt_b1[l], hy_filt_w2[l],
                 hy_filt_b2[l], hy_filt_freq[l], hy_filt_w3[l], hy_bias[l], na_rpb[l], swa_sink[l],
                 w_branch_a[l], w_branch_b[l], w_branch_c[l], w_out[l], ln1_g[l], ln1_b[l], w_up[l], b_up[l],
                 w_down[l], b_down[l], ln2_g[l], ln2_b[l])
        y_prompt = _encoder_block(y_prompt, *layer)
        y_sample = _encoder_block(y_sample, *layer)
    return (y_prompt, y_sample)
```

```cpp
#include <hip/hip_runtime.h>
#include <cstdio>
#include <cstdint>
#include <type_traits>
namespace pg8 {
#define PG8_LAS __attribute__((address_space(3)))
typedef unsigned short bf16_t;
typedef short bf16x8 __attribute__((ext_vector_type(8)));
typedef float f32x4 __attribute__((ext_vector_type(4)));
typedef unsigned u32x4 __attribute__((ext_vector_type(4)));
constexpr int BM = 256, BK = 64, HALF = 128, HTB = HALF * BK * 2  , STAGE_BYTES = 8 * HTB, NXCD = 8, WGM = 8;

__host__ __device__ __forceinline__ int lds_byte(int r, int c) { const int st = (r >> 4) * 2 + (c >> 5), rr = r & 15, cc = c & 31, ob = rr * 64 + cc * 2; return st * 1024 + (ob ^ (((ob >> 9) & 1) << 5)); }
__host__ __device__ __forceinline__ void stage_rc(int b, int& R, int& C) { const int st = b / 1024, sb = b % 1024, swz = sb ^ (((sb >> 9) & 1) << 5); R = (st >> 1) * 16 + swz / 64; C = (st & 1) * 32 + (swz % 64) / 2; }
__host__ __device__ __forceinline__ int perm32(int rho) { const int n = rho >> 4, i = rho & 15; return 8 * (i >> 2) + 4 * n + (i & 3); }

struct Unit { int pm, pn; };
struct Gemm { const bf16_t* A; const bf16_t* Bt; int M, N, K; };

struct StaticOrder {
    int nM, nN, nwg, G, c;
    __host__ __device__ void init(int M, int N, int G_, int c_) { nM = M / BM; nN = N / BM; nwg = nM * nN; G = G_; c = c_; }
    __host__ __device__ bool next(int i, Unit& u) const {
        const long L = (long)i * G + c; if (L >= nwg) return false;
        int wgid = (int)L; { const int q = nwg / NXCD, r = nwg % NXCD, xcd = wgid % NXCD, off = wgid / NXCD; wgid = (xcd < r ? xcd * (q + 1) : r * (q + 1) + (xcd - r) * q) + off; }
        const int nig = WGM * nN, gid = wgid / nig, fm = gid * WGM, gsz = (nM - fm) < WGM ? (nM - fm) : WGM;
        u.pm = fm + ((wgid % nig) % gsz); u.pn = (wgid % nig) / gsz; return true;
    }
    __device__ __forceinline__ void a_ready(const Unit&) const {}
    __device__ __forceinline__ void done(const Unit&) const {}
};

__device__ __forceinline__ unsigned cvt_pk_bf16(float lo, float hi) { unsigned r; asm volatile("v_cvt_pk_bf16_f32 %0, %1, %2" : "=v"(r) : "v"(lo), "v"(hi)); return r; }
typedef float f32x2 __attribute__((ext_vector_type(2)));

__device__ __forceinline__ float sigmoid_f(float v) { return __builtin_amdgcn_rcpf(1.0f + __builtin_amdgcn_exp2f(-1.4426950408889634f * v)); }

template <int MODE> struct EpiAct {
    static constexpr bool PERM = true, AFTER_DRAIN = false;
    bf16_t* O; int ldc; const float* bias; int gate_pn0;
    __device__ __forceinline__ bool zero_after(const Unit&) const { return true; }
    __device__ __forceinline__ void operator()(f32x4 (&acc)[2][2][4][2], const Unit& u, int wr, int wc, int fr, int fq) const {
        const int row0 = u.pm * BM + wr * 64 + fr, col0 = u.pn * BM + wc * 32 + 8 * fq;
        const bool gate = (MODE == 0) && (u.pn >= gate_pn0);
        f32x4 bv[2][2];
#pragma unroll
        for (int bj = 0; bj < 2; ++bj)
#pragma unroll
            for (int n = 0; n < 2; ++n) bv[bj][n] = *(const f32x4*)(bias + col0 + bj * HALF + 4 * n);
#pragma unroll
        for (int ai = 0; ai < 2; ++ai)
#pragma unroll
            for (int m = 0; m < 4; ++m) { bf16_t* rowp = O + (size_t)(row0 + ai * HALF + m * 16) * ldc + col0;
#pragma unroll
                for (int bj = 0; bj < 2; ++bj) { f32x4 v0 = acc[ai][bj][m][0] + bv[bj][0], v1 = acc[ai][bj][m][1] + bv[bj][1];
                    if (MODE == 1) {
#pragma unroll
                        for (int e = 0; e < 4; ++e) { const float a0 = fmaxf(v0[e], 0.f), a1 = fmaxf(v1[e], 0.f); v0[e] = a0 * a0; v1[e] = a1 * a1; }
                    } else if (gate) {
#pragma unroll
                        for (int e = 0; e < 4; ++e) { v0[e] = sigmoid_f(v0[e]); v1[e] = sigmoid_f(v1[e]); }
                    }
                    u32x4 w; w.x = cvt_pk_bf16(v0[0], v0[1]); w.y = cvt_pk_bf16(v0[2], v0[3]); w.z = cvt_pk_bf16(v1[0], v1[1]); w.w = cvt_pk_bf16(v1[2], v1[3]);
                    *(u32x4*)(rowp + bj * HALF) = w; } }
    }
};

struct EpiRes {
    static constexpr bool PERM = false, AFTER_DRAIN = false;
    const float* X; float* out; int ldc; const float* bias; float alpha;
    __device__ __forceinline__ bool zero_after(const Unit&) const { return true; }
    __device__ __forceinline__ void operator()(f32x4 (&acc)[2][2][4][2], const Unit& u, int wr, int wc, int fr, int fq) const {
        const int row0 = u.pm * BM + wr * 64 + fr, col0 = u.pn * BM + wc * 32 + 4 * fq;
        f32x4 bv[2][2];
#pragma unroll
        for (int bj = 0; bj < 2; ++bj)
#pragma unroll
            for (int n = 0; n < 2; ++n) bv[bj][n] = bias ? *(const f32x4*)(bias + col0 + bj * HALF + n * 16) : (f32x4){0.f, 0.f, 0.f, 0.f};
#pragma unroll
        for (int ai = 0; ai < 2; ++ai)
#pragma unroll
            for (int m = 0; m < 4; ++m) { const size_t off = (size_t)(row0 + ai * HALF + m * 16) * ldc + col0;
#pragma unroll
                for (int bj = 0; bj < 2; ++bj)
#pragma unroll
                    for (int n = 0; n < 2; ++n) { const f32x4 x = *(const f32x4*)(X + off + bj * HALF + n * 16);
                        *(f32x4*)(out + off + bj * HALF + n * 16) = x * alpha + acc[ai][bj][m][n] + bv[bj][n]; }
                asm volatile("" ::: "memory"); }
    }
};

__device__ __forceinline__ float bf_lo(unsigned w) { return __uint_as_float(w << 16); }
__device__ __forceinline__ float bf_hi(unsigned w) { return __uint_as_float(w & 0xffff0000u); }
struct EpiMerge {
    static constexpr bool PERM = true, AFTER_DRAIN = false;
    bf16_t* O; const bf16_t* G; int ldg; int npm;
    __device__ __forceinline__ bool zero_after(const Unit& u) const { return (u.pn >> 2) == 2; }
    __device__ __forceinline__ void operator()(f32x4 (&acc)[2][2][4][2], const Unit& u, int wr, int wc, int fr, int fq) const {
        const int br = u.pn >> 2, pn = u.pn & 3, pm = u.pm - br * npm;
        const int row0 = pm * BM + wr * 64 + fr, col0 = pn * BM + wc * 32 + 8 * fq;
#pragma unroll
        for (int ai = 0; ai < 2; ++ai)
#pragma unroll
            for (int m = 0; m < 4; ++m) { const int row = row0 + ai * HALF + m * 16;
#pragma unroll
                for (int bj = 0; bj < 2; ++bj) { const int col = col0 + bj * HALF;
                    const u32x4 gc = *(const u32x4*)(G + (size_t)row * ldg + br * 1024 + col);
                    float f[8];
                    f[0] = bf_lo(gc.x); f[1] = bf_hi(gc.x); f[2] = bf_lo(gc.y); f[3] = bf_hi(gc.y); f[4] = bf_lo(gc.z); f[5] = bf_hi(gc.z); f[6] = bf_lo(gc.w); f[7] = bf_hi(gc.w);
#pragma unroll
                    for (int e = 0; e < 8; ++e) f[e] = fmaxf(f[e], 1e-30f);
                    if (br < 2) { const u32x4 gn = *(const u32x4*)(G + (size_t)row * ldg + (br + 1) * 1024 + col);
                        float d[8];
                        d[0] = bf_lo(gn.x); d[1] = bf_hi(gn.x); d[2] = bf_lo(gn.y); d[3] = bf_hi(gn.y); d[4] = bf_lo(gn.z); d[5] = bf_hi(gn.z); d[6] = bf_lo(gn.w); d[7] = bf_hi(gn.w);
#pragma unroll
                        for (int e = 0; e < 8; ++e) f[e] = f[e] * __builtin_amdgcn_rcpf(fmaxf(d[e], 1e-30f)); }
                    f32x4 v0 = acc[ai][bj][m][0], v1 = acc[ai][bj][m][1];
#pragma unroll
                    for (int e = 0; e < 4; ++e) { v0[e] *= f[e]; v1[e] *= f[4 + e]; }
                    acc[ai][bj][m][0] = v0; acc[ai][bj][m][1] = v1;
                    if (br == 2) { u32x4 w; w.x = cvt_pk_bf16(v0[0], v0[1]); w.y = cvt_pk_bf16(v0[2], v0[3]); w.z = cvt_pk_bf16(v1[0], v1[1]); w.w = cvt_pk_bf16(v1[2], v1[3]);
                        *(u32x4*)(O + (size_t)row * 1024 + col) = w; } }
                asm volatile("" ::: "memory"); }
    }
};
struct MergeOrder {
    int ntiles, G, c, npm;
    __device__ __forceinline__ void init(int npm_, int G_, int c_) { npm = npm_; ntiles = npm_ * 4; G = G_; c = c_; }
    __device__ __forceinline__ bool next(int i, Unit& u) const {
        const int tile = (i / 3) * G + c, br = i % 3; if (tile >= ntiles) return false;
        u.pm = br * npm + (tile >> 2); u.pn = br * 4 + (tile & 3); return true;
    }
    __device__ __forceinline__ void a_ready(const Unit&) const {}
    __device__ __forceinline__ void done(const Unit&) const {}
};
template <class Epi, class Sched, bool ALIGN_EPI = false, bool SP2 = false>
__device__ __forceinline__ void gemm_phase(PG8_LAS unsigned char* lds, const Gemm g, const Sched& S, const Epi& E) {
    int tid_l = threadIdx.x; asm volatile("" : "+v"(tid_l)); const int tid = tid_l, wid = __builtin_amdgcn_readfirstlane(tid >> 6), lane = tid & 63, wr = wid >> 2, wc = wid & 3, fr = lane & 15, fq = lane >> 4;
    const int K = g.K, nt = K / BK;
    unsigned voffA[2], voffB[2];
#pragma unroll
    for (int i = 0; i < 2; ++i) { int R, C; stage_rc(tid * 16 + i * 8192, R, C); const int Rb = Epi::PERM ? ((R & ~31) + perm32(R & 31)) : R;
        voffA[i] = (unsigned)(R * K + C) * 2u; voffB[i] = (unsigned)(Rb * K + C) * 2u; }
    const size_t kstep = (size_t)(BK * 2);
    const size_t hstep = (size_t)HALF * K * 2;
    const size_t tstep = 2 * hstep;
    const unsigned ldsw = (unsigned)wid * 1024u;
    const int aoff = lds_byte(wr * 64 + fr, fq * 8), boff = lds_byte(wc * 32 + fr, fq * 8);
#define PG8_SA(b, h) (((b) * 2 + (h)) * HTB)
#define PG8_SB(b, h) ((4 + (b) * 2 + (h)) * HTB)
#define PG8_STAGE(bufoff, gbase, voff) do { _Pragma("unroll") for (int _i = 0; _i < 2; ++_i) \
        __builtin_amdgcn_global_load_lds((const unsigned*)((const char*)(gbase) + (voff)[_i]), (PG8_LAS unsigned*)(lds + (bufoff) + ldsw + _i * 8192), 16, 0, 0); } while (0)
#define PG8_LDA(dst, b, h) do { _Pragma("unroll") for (int m = 0; m < 4; ++m) _Pragma("unroll") for (int k = 0; k < 2; ++k) dst[m][k] = *(const PG8_LAS bf16x8*)(lds + PG8_SA(b, h) + aoff + m * 2048 + k * 1024); } while (0)
#define PG8_LDB(dst, b, h) do { _Pragma("unroll") for (int n = 0; n < 2; ++n) _Pragma("unroll") for (int k = 0; k < 2; ++k) dst[n][k] = *(const PG8_LAS bf16x8*)(lds + PG8_SB(b, h) + boff + n * 2048 + k * 1024); } while (0)
#define PG8_MMA(ai, bj, At, Bt) do { __builtin_amdgcn_s_setprio(1); _Pragma("unroll") for (int m = 0; m < 4; ++m) _Pragma("unroll") for (int n = 0; n < 2; ++n) _Pragma("unroll") for (int k = 0; k < 2; ++k) \
        acc[ai][bj][m][n] = __builtin_amdgcn_mfma_f32_16x16x32_bf16(Bt[n][k], At[m][k], acc[ai][bj][m][n], 0, 0, 0); __builtin_amdgcn_s_setprio(0); } while (0)
#define PG8_WAIT_V(n) asm volatile("s_waitcnt vmcnt(" #n ")" ::: "memory")
#define PG8_WAIT_L(n) asm volatile("s_waitcnt lgkmcnt(" #n ")" ::: "memory")
#define PG8_BAR __builtin_amdgcn_s_barrier()
#define PG8_SCHED __builtin_amdgcn_sched_barrier(0)
    Unit cur, nxt; int ui = 0;
    if (!S.next(0, cur)) return;
    f32x4 acc[2][2][4][2];
#pragma unroll
    for (int a = 0; a < 2; ++a)
#pragma unroll
        for (int b = 0; b < 2; ++b)
#pragma unroll
            for (int m = 0; m < 4; ++m)
#pragma unroll
                for (int n = 0; n < 2; ++n) acc[a][b][m][n] = (f32x4){0.f, 0.f, 0.f, 0.f};
    bf16x8 At[4][2], B0[2][2], B1[2][2];
    const char* cA = (const char*)g.A + (size_t)cur.pm * tstep; const char* cB = (const char*)g.Bt + (size_t)cur.pn * tstep;
    S.a_ready(cur);
    if constexpr (SP2) {
        PG8_STAGE(PG8_SB(0, 0), cB, voffB); PG8_STAGE(PG8_SB(0, 1), cB + hstep, voffB); PG8_STAGE(PG8_SA(0, 0), cA, voffA); PG8_STAGE(PG8_SA(0, 1), cA + hstep, voffA);
        if (wr == 1) PG8_BAR;
        PG8_WAIT_V(2); PG8_BAR;
        PG8_STAGE(PG8_SB(1, 0), cB + kstep, voffB); PG8_STAGE(PG8_SA(1, 0), cA + kstep, voffA); PG8_STAGE(PG8_SB(1, 1), cB + hstep + kstep, voffB);
        PG8_WAIT_V(6); PG8_BAR;
    } else {
        PG8_STAGE(PG8_SB(0, 0), cB, voffB); PG8_STAGE(PG8_SA(0, 0), cA, voffA); PG8_STAGE(PG8_SB(0, 1), cB + hstep, voffB); PG8_STAGE(PG8_SA(0, 1), cA + hstep, voffA);
        if (wr == 1) PG8_BAR;
        PG8_WAIT_V(4); PG8_BAR;
        PG8_STAGE(PG8_SB(1, 0), cB + kstep, voffB); PG8_STAGE(PG8_SA(1, 0), cA + kstep, voffA); PG8_STAGE(PG8_SB(1, 1), cB + hstep + kstep, voffB);
        PG8_WAIT_V(6); PG8_BAR;
    }
    for (;;) {
        const bool has_next = S.next(ui + 1, nxt);
        const char* nA = has_next ? (const char*)g.A + (size_t)nxt.pm * tstep : cA; const char* nB = has_next ? (const char*)g.Bt + (size_t)nxt.pn * tstep : cB;
        for (int t = 0; t < nt; t += 2) {
            const bool last = (t == nt - 2);
            const char* a1 = cA + (size_t)(t + 1) * kstep;
            const char* a2 = last ? nA : cA + (size_t)(t + 2) * kstep; const char* b2 = last ? nB : cB + (size_t)(t + 2) * kstep;
            const char* a3 = a2 + kstep; const char* b3 = b2 + kstep;
            if (last && has_next) S.a_ready(nxt);
            if constexpr (SP2) {
            PG8_LDB(B0, 0, 0); PG8_LDB(B1, 0, 1); PG8_SCHED; PG8_LDA(At, 0, 0); PG8_STAGE(PG8_SA(1, 1), a1 + hstep, voffA);
            PG8_WAIT_V(8); PG8_WAIT_L(0); PG8_BAR; PG8_MMA(0, 0, At, B0); PG8_MMA(0, 1, At, B1); PG8_BAR; PG8_SCHED;
            PG8_LDA(At, 0, 1); PG8_STAGE(PG8_SB(0, 0), b2, voffB); PG8_STAGE(PG8_SB(0, 1), b2 + hstep, voffB); PG8_STAGE(PG8_SA(0, 0), a2, voffA);
            PG8_WAIT_V(8); PG8_WAIT_L(0); PG8_BAR; PG8_MMA(1, 0, At, B0); PG8_MMA(1, 1, At, B1); PG8_BAR; PG8_SCHED;
            PG8_LDB(B0, 1, 0); PG8_LDB(B1, 1, 1); PG8_SCHED; PG8_LDA(At, 1, 0); PG8_STAGE(PG8_SA(0, 1), a2 + hstep, voffA);
            PG8_WAIT_V(8); PG8_WAIT_L(0); PG8_BAR; PG8_MMA(0, 0, At, B0); PG8_MMA(0, 1, At, B1); PG8_BAR; PG8_SCHED;
            PG8_LDA(At, 1, 1); PG8_STAGE(PG8_SB(1, 0), b3, voffB); PG8_STAGE(PG8_SB(1, 1), b3 + hstep, voffB); PG8_STAGE(PG8_SA(1, 0), a3, voffA);
            PG8_WAIT_V(8); PG8_WAIT_L(0); PG8_BAR; PG8_MMA(1, 0, At, B0); PG8_MMA(1, 1, At, B1); PG8_BAR; PG8_SCHED;
            } else {
            PG8_LDB(B0, 0, 0); PG8_SCHED; PG8_LDA(At, 0, 0); PG8_STAGE(PG8_SA(1, 1), a1 + hstep, voffA);
            PG8_WAIT_L(8); PG8_BAR; PG8_WAIT_L(0); PG8_MMA(0, 0, At, B0); PG8_BAR; PG8_SCHED;
            PG8_LDB(B1, 0, 1); PG8_STAGE(PG8_SB(0, 0), b2, voffB);
            PG8_BAR; PG8_WAIT_L(0); PG8_MMA(0, 1, At, B1); PG8_BAR;
            PG8_LDA(At, 0, 1); PG8_STAGE(PG8_SA(0, 0), a2, voffA);
            PG8_BAR; PG8_WAIT_L(0); PG8_MMA(1, 0, At, B0); PG8_BAR; PG8_SCHED;
            PG8_STAGE(PG8_SB(0, 1), b2 + hstep, voffB);
            PG8_WAIT_V(6); PG8_BAR; PG8_MMA(1, 1, At, B1); PG8_BAR;
            PG8_LDB(B0, 1, 0); PG8_SCHED; PG8_LDA(At, 1, 0); PG8_STAGE(PG8_SA(0, 1), a2 + hstep, voffA);
            PG8_WAIT_L(8); PG8_BAR; PG8_WAIT_L(0); PG8_MMA(0, 0, At, B0); PG8_BAR; PG8_SCHED;
            PG8_LDB(B1, 1, 1); PG8_STAGE(PG8_SB(1, 0), b3, voffB);
            PG8_BAR; PG8_WAIT_L(0); PG8_MMA(0, 1, At, B1); PG8_BAR;
            PG8_LDA(At, 1, 1); PG8_STAGE(PG8_SA(1, 0), a3, voffA);
            PG8_BAR; PG8_WAIT_L(0); PG8_MMA(1, 0, At, B0); PG8_BAR; PG8_SCHED;
            PG8_STAGE(PG8_SB(1, 1), b3 + hstep, voffB);
            PG8_WAIT_V(6); PG8_BAR; PG8_MMA(1, 1, At, B1); PG8_BAR;
            }
        }
        if constexpr (ALIGN_EPI) { if (wr == 0) PG8_BAR; }
        if constexpr (!Epi::AFTER_DRAIN) { E(acc, cur, wr, wc, fr, fq); S.done(cur); }
        if (!has_next) break;
        if (E.zero_after(cur)) {
#pragma unroll
        for (int a = 0; a < 2; ++a)
#pragma unroll
            for (int b = 0; b < 2; ++b)
#pragma unroll
                for (int m = 0; m < 4; ++m)
#pragma unroll
                    for (int n = 0; n < 2; ++n) acc[a][b][m][n] = (f32x4){0.f, 0.f, 0.f, 0.f};
        }
        cur = nxt; cA = nA; cB = nB; ++ui;
        if constexpr (ALIGN_EPI) { if (wr == 1) PG8_BAR; }
    }
    PG8_WAIT_V(0);
    if constexpr (!ALIGN_EPI) { if (wr == 0) PG8_BAR; }
    PG8_BAR;
    if constexpr (Epi::AFTER_DRAIN) { E.fused(acc, cur, wr, wc, fr, fq, lds, wid, lane); S.done(cur); }
#undef PG8_SA
#undef PG8_SB
#undef PG8_STAGE
#undef PG8_LDA
#undef PG8_LDB
#undef PG8_MMA
#undef PG8_WAIT_V
#undef PG8_WAIT_L
#undef PG8_BAR
#undef PG8_SCHED
}
}
#define GAS __attribute__((address_space(1)))
#define LAS __attribute__((address_space(3)))
typedef unsigned short bf16;
typedef unsigned v4u __attribute__((ext_vector_type(4)));
typedef float f32x4 __attribute__((ext_vector_type(4)));
typedef short bf16x8 __attribute__((ext_vector_type(8)));
typedef GAS unsigned gu32;
typedef GAS unsigned long long gu64;
#define RLX_AGENT __ATOMIC_RELAXED, __HIP_MEMORY_SCOPE_AGENT
#define LDS_WAIT() asm volatile("s_waitcnt lgkmcnt(0)" ::: "memory")
#define VM_WAIT() asm volatile("s_waitcnt vmcnt(0)" ::: "memory")
__device__ __forceinline__ unsigned long long rt() { return __builtin_amdgcn_s_memrealtime(); }
__device__ __forceinline__ unsigned f2bf(float f) { unsigned u = __builtin_bit_cast(unsigned, f); return (u + 0x7fffu + ((u >> 16) & 1u)) >> 16; }
__device__ __forceinline__ unsigned pk2(float lo, float hi) { return f2bf(lo) | (f2bf(hi) << 16); }
#define XB_TMO      128
#define XB_XCNT(j)  (256  + 64 * (j))
#define XB_XSUB(j)  (1280 + 64 * (j))
#define XB_XGEN(j)  (2304 + 64 * (j))
#define XB_TOP      3328
#define XB_TOPGEN   3392
#define XCD_BAR_WORDS 3456
#define XB_SPIN_CAP (1u << 20)

__device__ __forceinline__ unsigned xb_ld(unsigned* p)              { return __hip_atomic_load(p, __ATOMIC_RELAXED, __HIP_MEMORY_SCOPE_AGENT); }
__device__ __forceinline__ unsigned xb_add(unsigned* p, unsigned v) { return __hip_atomic_fetch_add(p, v, __ATOMIC_RELAXED, __HIP_MEMORY_SCOPE_AGENT); }
__device__ __forceinline__ unsigned xb_xcc_id() { return (unsigned)__builtin_amdgcn_s_getreg((3 << 11) | 20) & 0xFu; }
#define XB_SPIN(cond, bar) do { unsigned _sp = 0; while (cond) { __builtin_amdgcn_s_sleep(1); \
    if ((++_sp & 255u) == 0u) { if (xb_ld(&(bar)[XB_TMO])) break; if (_sp > XB_SPIN_CAP) { atomicAdd(&(bar)[XB_TMO], 1u); break; } } } } while (0)

struct XcdBarrier {
    unsigned* bar; unsigned x;
    volatile LAS unsigned* st;
};

__device__ __forceinline__ XcdBarrier xcd_barrier_post(unsigned* bar, volatile LAS unsigned* st) {
    XcdBarrier b; b.bar = bar; b.x = xb_xcc_id(); b.st = st;
    if (threadIdx.x == 0) (void)xb_add(&bar[XB_XCNT(b.x)], 1u);
    return b;
}
__device__ __forceinline__ void xcd_barrier_complete(unsigned* bar, unsigned x, unsigned& nloc, unsigned& nx) {
    const unsigned G = gridDim.x * gridDim.y * gridDim.z;
    unsigned sum, cnt, mine, sp = 0u;
    for (;;) {
        sum = 0u; cnt = 0u; mine = 0u;
#pragma unroll
        for (unsigned j = 0; j < 16; ++j) { const unsigned c = xb_ld(&bar[XB_XCNT(j)]); sum += c; cnt += (c > 0u) ? 1u : 0u; mine = (j == x) ? c : mine; }
        if (sum == G) break;
        __builtin_amdgcn_s_sleep(1);
        if ((++sp & 255u) == 0u) { if (xb_ld(&bar[XB_TMO])) break; if (sp > XB_SPIN_CAP) { atomicAdd(&bar[XB_TMO], 1u); break; } }
    }
    nloc = mine > 0u ? mine : 1u; nx = cnt > 0u ? cnt : 1u;
}

__device__ __forceinline__ void xcd_barrier(const XcdBarrier& b) {
    asm volatile("s_waitcnt vmcnt(0)" ::: "memory");
    __syncthreads();
    if (threadIdx.x == 0) {
        unsigned* bar = b.bar;
        __builtin_amdgcn_s_waitcnt(0);
        unsigned nloc = b.st[0], nx = b.st[1];
        if (nloc == 0u) { xcd_barrier_complete(bar, b.x, nloc, nx); b.st[0] = nloc; b.st[1] = nx; }
        const unsigned old = xb_add(&bar[XB_XSUB(b.x)], 1u);
        const unsigned gen = old / nloc;
        if (old + 1u == (gen + 1u) * nloc) {
            __builtin_amdgcn_fence(__ATOMIC_RELEASE, "agent");
            asm volatile("s_waitcnt vmcnt(0)" ::: "memory");
            const unsigned og = xb_add(&bar[XB_TOP], 1u);
            const unsigned tg = og / nx;
            if (og + 1u == (tg + 1u) * nx) xb_add(&bar[XB_TOPGEN], 1u);
            else XB_SPIN(xb_ld(&bar[XB_TOPGEN]) == tg, bar);
            __builtin_amdgcn_fence(__ATOMIC_ACQUIRE, "agent");
            xb_add(&bar[XB_XGEN(b.x)], 1u);
            asm volatile("s_waitcnt vmcnt(0)" ::: "memory");
        } else {
            XB_SPIN(xb_ld(&bar[XB_XGEN(b.x)]) == gen, bar);
            __builtin_amdgcn_fence(__ATOMIC_ACQUIRE, "agent");
            asm volatile("s_waitcnt vmcnt(0)" ::: "memory");
        }
    }
    __syncthreads();
}
namespace hy {
typedef float f2 __attribute__((ext_vector_type(2)));
#ifdef CPU_EMU
#define HY_DEV
#define HY_LAS
static inline float cos2pi(float f) { return (float)cos(6.283185307179586 * (double)f); }
static inline float sin2pi(float f) { return (float)sin(6.283185307179586 * (double)f); }
#else
#define HY_DEV __device__ __forceinline__
#define HY_LAS __attribute__((address_space(3)))
HY_DEV float cos2pi(float f) { return __builtin_amdgcn_cosf(f); }
HY_DEV float sin2pi(float f) { return __builtin_amdgcn_sinf(f); }
#endif
typedef HY_LAS f2* ldsf2;

constexpr float FC32[16] = {1.0f, 0.98078528040323043f, 0.92387953251128674f, 0.83146961230254524f, 0.70710678118654752f, 0.55557023301960222f, 0.38268343236508977f, 0.19509032201612825f,
                            0.0f, -0.19509032201612825f, -0.38268343236508977f, -0.55557023301960222f, -0.70710678118654752f, -0.83146961230254524f, -0.92387953251128674f, -0.98078528040323043f};
constexpr float FS32[16] = {0.0f, 0.19509032201612825f, 0.38268343236508977f, 0.55557023301960222f, 0.70710678118654752f, 0.83146961230254524f, 0.92387953251128674f, 0.98078528040323043f,
                            1.0f, 0.98078528040323043f, 0.92387953251128674f, 0.83146961230254524f, 0.70710678118654752f, 0.55557023301960222f, 0.38268343236508977f, 0.19509032201612825f};

template <int R> struct Log2 { static constexpr int v = 1 + Log2<R / 2>::v; };
template <> struct Log2<1> { static constexpr int v = 0; };
template <int R> HY_DEV constexpr int brev(int r) { int o = 0; for (int b = 0; b < Log2<R>::v; ++b) o |= ((r >> b) & 1) << (Log2<R>::v - 1 - b); return o; }

template <int R> HY_DEV void dft_dif(float (&re)[R], float (&im)[R]) {
#pragma unroll
    for (int st = 0; st < Log2<R>::v; ++st) {
        const int len = R >> st, half = len >> 1, step = 32 / len;
#pragma unroll
        for (int blk = 0; blk < R; blk += len)
#pragma unroll
            for (int j = 0; j < half; ++j) {
                const int i0 = blk + j, i1 = i0 + half;
                const float ar = re[i0], ai = im[i0], br = re[i1], bi = im[i1];
                re[i0] = ar + br; im[i0] = ai + bi;
                const float tr = ar - br, ti = ai - bi;
                if (j == 0) { re[i1] = tr; im[i1] = ti; }
                else if (4 * j == len) { re[i1] = ti; im[i1] = -tr; }
                else { const float c = FC32[j * step], s = FS32[j * step]; re[i1] = tr * c + ti * s; im[i1] = ti * c - tr * s; }
            }
    }
}
template <int R> HY_DEV void dft_dit_inv(float (&re)[R], float (&im)[R]) {
#pragma unroll
    for (int st = Log2<R>::v - 1; st >= 0; --st) {
        const int len = R >> st, half = len >> 1, step = 32 / len;
#pragma unroll
        for (int blk = 0; blk < R; blk += len)
#pragma unroll
            for (int j = 0; j < half; ++j) {
                const int i0 = blk + j, i1 = i0 + half;
                const float ar = re[i0], ai = im[i0], xr = re[i1], xi = im[i1];
                float br, bi;
                if (j == 0) { br = xr; bi = xi; }
                else if (4 * j == len) { br = -xi; bi = xr; }
                else { const float c = FC32[j * step], s = FS32[j * step]; br = xr * c - xi * s; bi = xi * c + xr * s; }
                re[i0] = ar + br; im[i0] = ai + bi; re[i1] = ar - br; im[i1] = ai - bi;
            }
    }
}

struct P16 { static HY_DEV int phys(int i) { return i + (i >> 4) + ((i >> 9) << 4); } static constexpr int SIZE = 16384 + 1024 + 512, SH1 = 4, M2 = -1; };
struct P4  { static HY_DEV int phys(int i) { return i + (i >> 3); } static constexpr int SIZE = 4096 + 512, SH1 = 3, M2 = 0; };

template <int R, int NB, bool INV> HY_DEV void twiddle(float (&re)[R], float (&im)[R], int n2) {
#ifndef CPU_EMU
    asm volatile("" : "+v"(n2));
#endif
#pragma unroll
    for (int r = 1; r < R; ++r) {
        const int k1 = brev<R>(r);
        const float f = (float)(n2 * k1) * (1.0f / (float)NB);
        const float c = cos2pi(f), s = sin2pi(f);
        const float xr = re[r], xi = im[r];
        if (!INV) { re[r] = xr * c + xi * s; im[r] = xi * c - xr * s; }
        else      { re[r] = xr * c - xi * s; im[r] = xi * c + xr * s; }
    }
}
template <int R, int M, class PH> HY_DEV void lds_load(ldsf2 X, int base, float (&re)[R], float (&im)[R]) {
    const int pb = PH::phys(base); constexpr int PS = M + (M >> PH::SH1) + (((M >> 9) << 4) & PH::M2);
#pragma unroll
    for (int r = 0; r < R; ++r) { const f2 v = X[pb + PS * r]; re[r] = v.x; im[r] = v.y; }
}
template <int R, int M, class PH> HY_DEV void lds_store(ldsf2 X, int base, const float (&re)[R], const float (&im)[R]) {
    const int pb = PH::phys(base); constexpr int PS = M + (M >> PH::SH1) + (((M >> 9) << 4) & PH::M2);
#pragma unroll
    for (int r = 0; r < R; ++r) { f2 v; v.x = re[r]; v.y = im[r]; X[pb + PS * r] = v; }
}
template <int R, int LOGM, class PH> HY_DEV void fwd_from_regs(ldsf2 X, int item, float (&re)[R], float (&im)[R]) {
    constexpr int M = 1 << LOGM, NB = R * M;
    const int blk = item >> LOGM, n2 = item & (M - 1), base = blk * NB + n2;
    dft_dif<R>(re, im);
    if (LOGM > 0) twiddle<R, NB, false>(re, im, n2);
    lds_store<R, M, PH>(X, base, re, im);
}
template <int R, int LOGM, class PH> HY_DEV void fwd_pass(ldsf2 X, int item) {
    constexpr int M = 1 << LOGM, NB = R * M;
    const int blk = item >> LOGM, n2 = item & (M - 1), base = blk * NB + n2;
    float re[R], im[R];
    lds_load<R, M, PH>(X, base, re, im);
    fwd_from_regs<R, LOGM, PH>(X, item, re, im);
}
template <int R, int LOGM, class PH> HY_DEV void inv_to_regs(ldsf2 X, int item, float (&re)[R], float (&im)[R]) {
    constexpr int M = 1 << LOGM, NB = R * M;
    const int blk = item >> LOGM, n2 = item & (M - 1), base = blk * NB + n2;
    lds_load<R, M, PH>(X, base, re, im);
    if (LOGM > 0) twiddle<R, NB, true>(re, im, n2);
    dft_dit_inv<R>(re, im);
}
template <int R, int LOGM, class PH> HY_DEV void inv_pass(ldsf2 X, int item) {
    constexpr int M = 1 << LOGM, NB = R * M;
    const int blk = item >> LOGM, n2 = item & (M - 1), base = blk * NB + n2;
    float re[R], im[R];
    inv_to_regs<R, LOGM, PH>(X, item, re, im);
    lds_store<R, M, PH>(X, base, re, im);
}
template <int R, class PH> HY_DEV void mid_pass(ldsf2 X, int item, const f2* kf) {
    float re[R], im[R];
    lds_load<R, 1, PH>(X, item * R, re, im);
    dft_dif<R>(re, im);
    const f2* kp = kf + item * R;
#pragma unroll
    for (int r = 0; r < R; ++r) { const f2 k = kp[r]; const float xr = re[r], xi = im[r]; re[r] = xr * k.x - xi * k.y; im[r] = xr * k.y + xi * k.x; }
    dft_dit_inv<R>(re, im);
    lds_store<R, 1, PH>(X, item * R, re, im);
}
}

constexpr int NWAVES = 8;
constexpr int DM = 1024, DIN = 6912, DFF = 4096, NLAYER = 2;
constexpr int T_PROMPT = 65536, T_ALL = 98304, L_P = 8192, L_S = 2048;
constexpr int CH = 16384, NCH = 6;
constexpr int OFF_NAQ = 0, OFF_NAK = 512, OFF_NAV = 1024, OFF_HY = 1536, OFF_SWQ = 3072, OFF_SWK = 3584, OFF_SWV = 3712, OFF_GATE = 3840;
constexpr float LN_EPS = 1e-5f;
constexpr float DN_ALPHA = 1.4142135623730951f;

constexpr size_t MiB = 1u << 20;
constexpr size_t WS_CTL = 0, CTL_ZERO_BYTES = 65536;
constexpr size_t WS_WIN = 1 * MiB;
constexpr size_t WS_WBR = 28 * MiB;
constexpr size_t WS_WOUT = 34 * MiB;
constexpr size_t WS_WUP = 38 * MiB;
constexpr size_t WS_WDN = 54 * MiB;
constexpr size_t WS_H2 = 70 * MiB;
constexpr size_t WS_FT = 76 * MiB;
constexpr size_t WS_KF = 156 * MiB;
constexpr size_t WS_XB = 316 * MiB;
constexpr size_t WS_HP = 508 * MiB;
constexpr size_t WS_UT = 724 * MiB;
constexpr size_t WS_HBT = 772 * MiB;
constexpr size_t WS_BR = 788 * MiB;
constexpr size_t WS_MG = 836 * MiB;
constexpr size_t WS_END = 868 * MiB;
constexpr int CW_BAR = 4096;

constexpr int LDS_SCRATCH = 143360;
constexpr int LDS_MISC = LDS_SCRATCH;
constexpr int LDS_BYTES = 147456;

struct Args { const float* in[27]; float* out; unsigned char* ws; };
struct ArgsG { GAS const float* in[27]; GAS float* out; GAS unsigned char* ws; };
typedef __attribute__((address_space(4))) const ArgsG* cargs_t;
typedef unsigned long long u64;
typedef u64 u64x2 __attribute__((ext_vector_type(2)));
typedef float f32x16 __attribute__((ext_vector_type(16)));

__device__ __forceinline__ float bf2f(unsigned short b) { return __uint_as_float((unsigned)b << 16); }
__device__ __forceinline__ float wave_sum(float v) {
#pragma unroll
    for (int o = 1; o < 64; o <<= 1) v += __shfl_xor(v, o);
    return v;
}
__device__ __forceinline__ float sin_rev(float r) { r = r - floorf(r); return __builtin_amdgcn_sinf(r); }
__device__ __forceinline__ float cos_rev(float r) { r = r - floorf(r); return __builtin_amdgcn_cosf(r); }
constexpr float INV_2PI = 0.15915494309189535f;

__device__ __forceinline__ void p0_transpose_item(const float* W, int K, int N, bf16* WT, LAS float* scr, int item, int lane) {
    const int nblk = N / 32, kb = item / nblk, nb = item % nblk, k0 = 64 * kb, n0 = 32 * nb;
#pragma unroll 8
    for (int i = 0; i < 32; ++i) { const int kk = 2 * i + (lane >> 5); scr[kk * 33 + (lane & 31)] = W[(size_t)(k0 + kk) * N + n0 + (lane & 31)]; }
    LDS_WAIT(); asm volatile("" ::: "memory");
    const int c = lane & 7;
#pragma unroll
    for (int j = 0; j < 4; ++j) { const int n = (lane >> 3) + 8 * j; const LAS float* s = scr + (8 * c) * 33 + n;
        v4u o; o.x = pk2(s[0 * 33], s[1 * 33]); o.y = pk2(s[2 * 33], s[3 * 33]); o.z = pk2(s[4 * 33], s[5 * 33]); o.w = pk2(s[6 * 33], s[7 * 33]);
        *(v4u*)(WT + (size_t)(n0 + n) * K + k0 + 8 * c) = o; }
    LDS_WAIT(); asm volatile("" ::: "memory");
}
__device__ __forceinline__ void p0_prologue(cargs_t a, LAS unsigned char* lds, int gw, int NGW, int wave, int lane) {
    asm volatile("" : "+v"(lane)); asm volatile("" : "+s"(gw));
    unsigned char* ws = ((unsigned char*)a->ws);
    LAS float* scr = (LAS float*)(lds + wave * 16384);
    constexpr int I_IN = (DM / 64) * (DIN / 32), I_BR = (512 / 64) * (DM / 32), I_OUT = (DM / 64) * (DM / 32), I_UP = (DM / 64) * (DFF / 32), I_DN = (DFF / 64) * (DM / 32);
    constexpr int PER_LAYER = I_IN + 3 * I_BR + I_OUT + I_UP + I_DN;
    for (int it = gw; it < NLAYER * PER_LAYER; it += NGW) {
        const int l = it / PER_LAYER; int r = it % PER_LAYER;
        if (r < I_IN) { p0_transpose_item(((const float*)a->in[2]) + (size_t)l * DM * DIN, DM, DIN, (bf16*)(ws + WS_WIN) + (size_t)l * DIN * DM, scr, r, lane); continue; } r -= I_IN;
        if (r < 3 * I_BR) { const int b = r / I_BR; p0_transpose_item(((const float*)a->in[15 + b]) + (size_t)l * 512 * DM, 512, DM, (bf16*)(ws + WS_WBR) + (size_t)(l * 3 + b) * DM * 512, scr, r % I_BR, lane); continue; } r -= 3 * I_BR;
        if (r < I_OUT) { p0_transpose_item(((const float*)a->in[18]) + (size_t)l * DM * DM, DM, DM, (bf16*)(ws + WS_WOUT) + (size_t)l * DM * DM, scr, r, lane); continue; } r -= I_OUT;
        if (r < I_UP) { p0_transpose_item(((const float*)a->in[21]) + (size_t)l * DM * DFF, DM, DFF, (bf16*)(ws + WS_WUP) + (size_t)l * DFF * DM, scr, r, lane); continue; } r -= I_UP;
        p0_transpose_item(((const float*)a->in[23]) + (size_t)l * DFF * DM, DFF, DM, (bf16*)(ws + WS_WDN) + (size_t)l * DM * DFF, scr, r, lane);
    }
    bf16* XB = (bf16*)(ws + WS_XB);
    for (int m = gw; m < T_ALL; m += NGW) {
        const float* xr = (m < T_PROMPT) ? ((const float*)a->in[0]) + (size_t)m * DM : ((const float*)a->in[1]) + (size_t)(m - T_PROMPT) * DM;
        const f32x4* x4 = (const f32x4*)xr + lane; u64* o8 = (u64*)(XB + (size_t)m * DM) + lane;
#pragma unroll
        for (int j = 0; j < 4; ++j) { const f32x4 v = x4[64 * j]; o8[64 * j] = (u64)pk2(v.x, v.y) | ((u64)pk2(v.z, v.w) << 32); }
    }
    float* H2 = (float*)(ws + WS_H2);
    for (int it = gw; it < NLAYER * (L_P + L_S); it += NGW) {
        const int l = it / (L_P + L_S), rr = it % (L_P + L_S), L = rr < L_P ? L_P : L_S, i = rr < L_P ? rr : rr - L_P;
        const float* w1 = ((const float*)a->in[6]) + l * 33 * 64; const float* b1 = ((const float*)a->in[7]) + l * 64; const float* w2 = ((const float*)a->in[8]) + l * 64 * 64; const float* b2 = ((const float*)a->in[9]) + l * 64; const float* fq = ((const float*)a->in[10]) + l * 64;
        const float t = (float)i / (float)(L - 1);
        const float w = 6.283185307179586f * (float)i / (float)L;
        float pre = b1[lane] + t * w1[lane];
#pragma unroll
        for (int k = 0; k < 16; ++k) { const float band = 1e-4f + (float)k * ((15.0f - 1e-4f) / 15.0f); const float rv = (w * band) * INV_2PI;
            pre += cos_rev(rv) * w1[(1 + k) * 64 + lane] - sin_rev(rv) * w1[(17 + k) * 64 + lane]; }
        const float fr = fq[lane];
        const float h1 = sin_rev(fr * pre * INV_2PI);
        float pre2 = b2[lane];
        for (int mm = 0; mm < 64; ++mm) pre2 += __shfl(h1, mm) * w2[mm * 64 + lane];
        H2[(size_t)it * 64 + lane] = sin_rev(fr * pre2 * INV_2PI);
    }
}

__device__ __forceinline__ void pf_filters(cargs_t a, int layer, int gw, int NGW, int lane) {
    asm volatile("" : "+v"(lane)); asm volatile("" : "+s"(gw));
    const float* w3 = ((const float*)a->in[11]) + (size_t)layer * 64 * 2048;
    constexpr int U_P = (L_P / 64) * 32, U_S = (L_S / 64) * 32;
    for (int it = gw; it < U_P + U_S; it += NGW) {
        const bool sm = it >= U_P; const int r = sm ? it - U_P : it, L = sm ? L_S : L_P, tt = r >> 5, jb = r & 31, t = tt * 64 + lane;
        const float* h2 = (const float*)(((unsigned char*)a->ws) + WS_H2) + ((size_t)layer * (L_P + L_S) + (sm ? L_P : 0) + t) * 64;
        float* FT = (float*)(((unsigned char*)a->ws) + WS_FT) + (sm ? (size_t)2048 * L_P : 0);
        float h[64];
#pragma unroll
        for (int k = 0; k < 16; ++k) { const f32x4 v = ((const f32x4*)h2)[k]; h[4 * k] = v.x; h[4 * k + 1] = v.y; h[4 * k + 2] = v.z; h[4 * k + 3] = v.w; }
        const float tf = (float)t / (float)(L - 1);
        for (int jj = 0; jj < 64; ++jj) {
            const int j = __builtin_amdgcn_readfirstlane(jb * 64 + jj);
            float acc = 0.f;
#pragma unroll
            for (int k = 0; k < 64; ++k) acc += h[k] * w3[k * 2048 + j];
            const int c = j & 511;
            const float delta = -3.0701134573253944f + (float)c * ((-15.350567286626972f + 3.0701134573253944f) / 511.0f);
            const float win = __builtin_amdgcn_exp2f(-tf * fabsf(delta) * 1.4426950408889634f);
            FT[(size_t)j * L + t] = acc * win;
        }
    }
}

template <int LOGN> __device__ __forceinline__ void spectrum_unit(cargs_t a, LAS unsigned char* lds, int n, int c) {
    constexpr int N = 1 << LOGN, L = N / 2, R = (LOGN == 14) ? 32 : 8;
    typedef typename std::conditional<LOGN == 14, hy::P16, hy::P4>::type PH;
    int tid = threadIdx.x; asm volatile("" : "+v"(tid));
    hy::ldsf2 X = (hy::ldsf2)lds;
    const float* FT = (const float*)(((unsigned char*)a->ws) + WS_FT) + (LOGN == 14 ? 0 : (size_t)2048 * L_P);
    const float* ff = FT + (size_t)(n * 1024 + c) * L; const float* fb = FT + (size_t)(n * 1024 + 512 + c) * L;
    hy::f2* KF = (hy::f2*)(((unsigned char*)a->ws) + WS_KF) + (LOGN == 14 ? 0 : (size_t)1024 * 16384) + (size_t)(n * 512 + c) * N;
    float re[R], im[R];
#pragma unroll
    for (int n1 = 0; n1 < R; ++n1) { const int t = 512 * n1 + tid; im[n1] = 0.f;
        if (n1 < R / 2) re[n1] = ff[t]; else re[n1] = (t == L) ? 0.f : fb[(t == L) ? 1 : N - t]; }
    hy::fwd_from_regs<R, 9, PH>(X, tid, re, im);
    __syncthreads();
    if (LOGN == 14) { hy::fwd_pass<32, 4, PH>(X, tid); __syncthreads(); hy::fwd_pass<16, 0, PH>(X, tid); hy::fwd_pass<16, 0, PH>(X, tid + 512); }
    else { hy::fwd_pass<8, 6, PH>(X, tid); __syncthreads(); hy::fwd_pass<8, 3, PH>(X, tid); __syncthreads(); hy::fwd_pass<8, 0, PH>(X, tid); }
    __syncthreads();
    const float sc = 1.0f / (float)N;
#pragma unroll 4
    for (int i = tid; i < N; i += 512) { const hy::f2 v = X[PH::phys(i)]; KF[i] = v * sc; }
    __syncthreads();
}

__device__ __forceinline__ void h1_tiles(cargs_t a, LAS unsigned char* lds, int layer, int L, int gw, int NGW, int wave, int lane) {
    asm volatile("" : "+v"(lane)); asm volatile("" : "+s"(gw));
    const bf16* HP = (const bf16*)(((unsigned char*)a->ws) + WS_HP); bf16* UT = (bf16*)(((unsigned char*)a->ws) + WS_UT);
    LAS unsigned char* raw = lds + wave * 16384;
    const float* cw = ((const float*)a->in[4]) + layer * 3 * 1536; const float* cb = ((const float*)a->in[5]) + layer * 1536;
    for (int tile = gw; tile < (CH / 64) * 24; tile += NGW) {
        const int tt = tile / 24, cbk = tile % 24, row0 = tt * 64, seq = row0 / L, t0 = row0 - seq * L;
        const int rr = lane >> 3, ch = lane & 7;
#pragma unroll
        for (int it = 0; it < 9; ++it) { const int lr = it * 8 + rr; const int tq = t0 + lr - 1;
            if (lr < 66) { v4u v = (v4u){0u, 0u, 0u, 0u};
                if (tq >= 0 && tq < L) v = *(const v4u*)(HP + (size_t)(row0 + lr - 1) * DIN + OFF_HY + cbk * 64 + ch * 8);
                *(LAS v4u*)(raw + lr * 128 + ch * 16) = v; } }
        LDS_WAIT(); asm volatile("" ::: "memory");
        const int col = cbk * 64 + lane;
        const float w0 = cw[col], w1 = cw[1536 + col], w2 = cw[2 * 1536 + col], bb = cb[col];
        const LAS unsigned short* rc = (const LAS unsigned short*)raw + lane;
        float xp = bf2f(rc[0]), xc = bf2f(rc[64]);
        bf16* dst = UT + ((size_t)(seq * 1536 + col)) * L + t0;
#pragma unroll
        for (int t8 = 0; t8 < 8; ++t8) { float u[8];
#pragma unroll
            for (int e = 0; e < 8; ++e) { const float xn = bf2f(rc[(t8 * 8 + e + 2) * 64]); u[e] = w0 * xp + w1 * xc + w2 * xn + bb; xp = xc; xc = xn; }
            v4u o; o.x = pk2(u[0], u[1]); o.y = pk2(u[2], u[3]); o.z = pk2(u[4], u[5]); o.w = pk2(u[6], u[7]);
            *(v4u*)(dst + t8 * 8) = o; }
        LDS_WAIT(); asm volatile("" ::: "memory");
    }
}

template <int LOGN> __device__ __forceinline__ void conv_passes(LAS unsigned char* lds, const hy::f2* kf, float (&re)[(LOGN == 14) ? 32 : 8], float (&im)[(LOGN == 14) ? 32 : 8]) {
    constexpr int R = (LOGN == 14) ? 32 : 8;
    typedef typename std::conditional<LOGN == 14, hy::P16, hy::P4>::type PH;
    int tid = threadIdx.x; asm volatile("" : "+v"(tid)); hy::ldsf2 X = (hy::ldsf2)lds;
    hy::fwd_from_regs<R, 9, PH>(X, tid, re, im);
    __syncthreads();
    if (LOGN == 14) {
        hy::fwd_pass<32, 4, PH>(X, tid); __syncthreads();
        hy::mid_pass<16, PH>(X, tid, kf); hy::mid_pass<16, PH>(X, tid + 512, kf); __syncthreads();
        hy::inv_pass<32, 4, PH>(X, tid); __syncthreads();
    } else {
        hy::fwd_pass<8, 6, PH>(X, tid); __syncthreads();
        hy::fwd_pass<8, 3, PH>(X, tid); __syncthreads();
        hy::mid_pass<8, PH>(X, tid, kf); __syncthreads();
        hy::inv_pass<8, 3, PH>(X, tid); __syncthreads();
        hy::inv_pass<8, 6, PH>(X, tid); __syncthreads();
    }
    hy::inv_to_regs<R, 9, PH>(X, tid, re, im);
    __syncthreads();
}
template <int LOGN> __device__ __forceinline__ void conv_unit(cargs_t a, LAS unsigned char* lds, int layer, int pair, int c) {
    constexpr int N = 1 << LOGN, L = N / 2, R = (LOGN == 14) ? 32 : 8, NH = R / 2;
    int tid = threadIdx.x; asm volatile("" : "+v"(tid));
    const bf16* UT = (const bf16*)(((unsigned char*)a->ws) + WS_UT); bf16* HBT = (bf16*)(((unsigned char*)a->ws) + WS_HBT);
    const hy::f2* KF = (const hy::f2*)(((unsigned char*)a->ws) + WS_KF) + (LOGN == 14 ? 0 : (size_t)1024 * 16384);
    const int s0 = 2 * pair, s1 = s0 + 1;
    const bf16* v0 = UT + (size_t)(s0 * 1536 + c) * L; const bf16* v1 = UT + (size_t)(s1 * 1536 + c) * L;
    const float bias0 = ((const float*)a->in[12])[(layer * 2 + 0) * 512 + c], bias1 = ((const float*)a->in[12])[(layer * 2 + 1) * 512 + c];
    float re[R], im[R];
#pragma unroll
    for (int n1 = 0; n1 < R; ++n1) { const int t = 512 * n1 + tid;
        if (n1 < NH) { re[n1] = bf2f(v0[t]); im[n1] = bf2f(v1[t]); } else { re[n1] = 0.f; im[n1] = 0.f; } }
    conv_passes<LOGN>(lds, KF + (size_t)(0 * 512 + c) * N, re, im);
    bf16* z0p = HBT + (size_t)(s0 * 512 + c) * L; bf16* z1p = HBT + (size_t)(s1 * 512 + c) * L;
#pragma unroll
    for (int n1 = 0; n1 < R; ++n1) { const int t = 512 * n1 + tid;
        if (n1 < NH) { const float g0 = bf2f(v0[(size_t)512 * L + t]), g1 = bf2f(v1[(size_t)512 * L + t]);
            const float za = g0 * (re[n1] + bias0 * bf2f(v0[t])), zb = g1 * (im[n1] + bias0 * bf2f(v1[t]));
            z0p[t] = (bf16)f2bf(za); z1p[t] = (bf16)f2bf(zb); re[n1] = za; im[n1] = zb; } else { re[n1] = 0.f; im[n1] = 0.f; } }
    conv_passes<LOGN>(lds, KF + (size_t)(1 * 512 + c) * N, re, im);
#pragma unroll
    for (int n1 = 0; n1 < NH; ++n1) { const int t = 512 * n1 + tid;
        const float g0 = bf2f(v0[(size_t)1024 * L + t]), g1 = bf2f(v1[(size_t)1024 * L + t]);
        const float za = bf2f(z0p[t]), zb = bf2f(z1p[t]);
        z0p[t] = (bf16)f2bf(g0 * (re[n1] + bias1 * za));
        z1p[t] = (bf16)f2bf(g1 * (im[n1] + bias1 * zb)); }
}

__device__ __forceinline__ void h3_tiles(cargs_t a, LAS unsigned char* lds, int L, int gw, int NGW, int wave, int lane) {
    asm volatile("" : "+v"(lane)); asm volatile("" : "+s"(gw));
    const bf16* HBT = (const bf16*)(((unsigned char*)a->ws) + WS_HBT); bf16* B1 = (bf16*)(((unsigned char*)a->ws) + WS_BR) + (size_t)CH * 512;
    LAS unsigned char* tl = lds + wave * 16384;
    for (int tile = gw; tile < (CH / 64) * 8; tile += NGW) {
        const int tt = tile >> 3, cbk = tile & 7, row0 = tt * 64, seq = row0 / L, t0 = row0 - seq * L;
        const bf16* src = HBT + (size_t)(seq * 512 + cbk * 64 + lane) * L + t0;
#pragma unroll
        for (int t8 = 0; t8 < 8; ++t8) { const v4u v = *(const v4u*)(src + t8 * 8);
            const unsigned wv[4] = {v.x, v.y, v.z, v.w};
#pragma unroll
            for (int e = 0; e < 4; ++e) { *(LAS unsigned short*)(tl + (t8 * 8 + 2 * e) * 128 + lane * 2) = (unsigned short)(wv[e] & 0xffffu);
                                          *(LAS unsigned short*)(tl + (t8 * 8 + 2 * e + 1) * 128 + lane * 2) = (unsigned short)(wv[e] >> 16); } }
        LDS_WAIT(); asm volatile("" ::: "memory");
        const int rr = lane >> 3, ch = lane & 7;
#pragma unroll
        for (int it = 0; it < 8; ++it) { const int r = it * 8 + rr; const v4u v = *(const LAS v4u*)(tl + r * 128 + ch * 16);
            *(v4u*)(B1 + (size_t)(row0 + r) * 512 + cbk * 64 + ch * 8) = v; }
        LDS_WAIT(); asm volatile("" ::: "memory");
    }
}

__device__ __forceinline__ void na_unit(cargs_t a, LAS unsigned char* lds, int layer, int unit, int L) {
    const bf16* HP = (const bf16*)(((unsigned char*)a->ws) + WS_HP); bf16* AO = (bf16*)(((unsigned char*)a->ws) + WS_BR);
    int tid_ = threadIdx.x; asm volatile("" : "+v"(tid_)); const int tid = tid_, lane = tid & 63, h = __builtin_amdgcn_readfirstlane(tid >> 6), fr = lane & 15, fq = lane >> 4;
    const int rows = L >> 6, row0 = unit << 6, seqbase = (row0 / L) * L, r = (row0 - seqbase) >> 6;
    int rs = r - 4; rs = rs < 0 ? 0 : rs; rs = rs > rows - 8 ? rows - 8 : rs;
    LAS unsigned short* Vt = (LAS unsigned short*)(lds + h * 16384);
    LAS float* rpbs = (LAS float*)(lds + h * 16384 + 8704);
    const float* rpbg = ((const float*)a->in[13]) + (size_t)(layer * 8 + h) * 465;
    for (int i = lane; i < 465; i += 64) rpbs[i] = rpbg[i];
    bf16x8 qf[4][2];
#pragma unroll
    for (int g = 0; g < 4; ++g)
#pragma unroll
        for (int ks = 0; ks < 2; ++ks) qf[g][ks] = *(const bf16x8*)(HP + (size_t)(row0 + 16 * g + fr) * DIN + OFF_NAQ + h * 64 + 32 * ks + 8 * fq);
    float mx[4] = {-3.0e38f, -3.0e38f, -3.0e38f, -3.0e38f};
    LDS_WAIT(); asm volatile("" ::: "memory");
    for (int i = 0; i < 8; ++i) {
        const bf16* kbase = HP + (size_t)(seqbase + (rs + i) * 64) * DIN + OFF_NAK + h * 64 + 8 * fq;
        const int rbase = (rs + i - r + 7) * 31;
#pragma unroll
        for (int g = 0; g < 4; ++g) {
            const int c0 = (g == 0) ? 0 : (g == 1) ? 8 : (g == 2) ? 24 : 32;
            const int w = 16 * g + fr; int cs = w - 8; cs = cs < 0 ? 0 : cs; cs = cs > 48 ? 48 : cs;
            f32x4 acc0 = (f32x4){0.f, 0.f, 0.f, 0.f}, acc1 = acc0;
#pragma unroll
            for (int ks = 0; ks < 2; ++ks) {
                const bf16x8 k0 = *(const bf16x8*)(kbase + (size_t)(c0 + fr) * DIN + 32 * ks), k1 = *(const bf16x8*)(kbase + (size_t)(c0 + 16 + fr) * DIN + 32 * ks);
                acc0 = __builtin_amdgcn_mfma_f32_16x16x32_bf16(k0, qf[g][ks], acc0, 0, 0, 0); acc1 = __builtin_amdgcn_mfma_f32_16x16x32_bf16(k1, qf[g][ks], acc1, 0, 0, 0); }
#pragma unroll
            for (int e = 0; e < 4; ++e) {
                const int kc0 = c0 + 4 * fq + e, kc1 = kc0 + 16;
                const bool ok0 = (kc0 >= cs) && (kc0 < cs + 16), ok1 = (kc1 >= cs) && (kc1 < cs + 16);
                const float s0 = acc0[e] * 0.125f + rpbs[ok0 ? rbase + kc0 - w + 15 : 0], s1 = acc1[e] * 0.125f + rpbs[ok1 ? rbase + kc1 - w + 15 : 0];
                mx[g] = ok0 ? fmaxf(mx[g], s0) : mx[g]; mx[g] = ok1 ? fmaxf(mx[g], s1) : mx[g]; }
        }
    }
#pragma unroll
    for (int g = 0; g < 4; ++g) { mx[g] = fmaxf(mx[g], __shfl_xor(mx[g], 16)); mx[g] = fmaxf(mx[g], __shfl_xor(mx[g], 32)); }
    float ls[4] = {0.f, 0.f, 0.f, 0.f};
    f32x4 O[4][4];
#pragma unroll
    for (int g = 0; g < 4; ++g)
#pragma unroll
        for (int d = 0; d < 4; ++d) O[g][d] = (f32x4){0.f, 0.f, 0.f, 0.f};
    for (int i = 0; i < 8; ++i) {
        const bf16* kbase = HP + (size_t)(seqbase + (rs + i) * 64) * DIN + OFF_NAK + h * 64 + 8 * fq;
        const bf16* vrow = HP + (size_t)(seqbase + (rs + i) * 64 + lane) * DIN + OFF_NAV + h * 64;
        const int rbase = (rs + i - r + 7) * 31;
#pragma unroll
        for (int it = 0; it < 8; ++it) { const bf16x8 v8 = *(const bf16x8*)(vrow + 8 * it);
#pragma unroll
            for (int e = 0; e < 8; ++e) Vt[(8 * it + e) * 68 + lane] = (unsigned short)v8[e]; }
        LDS_WAIT(); asm volatile("" ::: "memory");
#pragma unroll
        for (int g = 0; g < 4; ++g) {
            const int c0 = (g == 0) ? 0 : (g == 1) ? 8 : (g == 2) ? 24 : 32;
            const int w = 16 * g + fr; int cs = w - 8; cs = cs < 0 ? 0 : cs; cs = cs > 48 ? 48 : cs;
            f32x4 acc0 = (f32x4){0.f, 0.f, 0.f, 0.f}, acc1 = acc0;
#pragma unroll
            for (int ks = 0; ks < 2; ++ks) {
                const bf16x8 k0 = *(const bf16x8*)(kbase + (size_t)(c0 + fr) * DIN + 32 * ks), k1 = *(const bf16x8*)(kbase + (size_t)(c0 + 16 + fr) * DIN + 32 * ks);
                acc0 = __builtin_amdgcn_mfma_f32_16x16x32_bf16(k0, qf[g][ks], acc0, 0, 0, 0); acc1 = __builtin_amdgcn_mfma_f32_16x16x32_bf16(k1, qf[g][ks], acc1, 0, 0, 0); }
            float p[8];
#pragma unroll
            for (int e = 0; e < 4; ++e) {
                const int kc0 = c0 + 4 * fq + e, kc1 = kc0 + 16;
                const bool ok0 = (kc0 >= cs) && (kc0 < cs + 16), ok1 = (kc1 >= cs) && (kc1 < cs + 16);
                const float s0 = acc0[e] * 0.125f + rpbs[ok0 ? rbase + kc0 - w + 15 : 0], s1 = acc1[e] * 0.125f + rpbs[ok1 ? rbase + kc1 - w + 15 : 0];
                p[e] = ok0 ? __builtin_amdgcn_exp2f((s0 - mx[g]) * 1.4426950408889634f) : 0.f;
                p[4 + e] = ok1 ? __builtin_amdgcn_exp2f((s1 - mx[g]) * 1.4426950408889634f) : 0.f;
                ls[g] += p[e] + p[4 + e]; }
            v4u pw; pw.x = pk2(p[0], p[1]); pw.y = pk2(p[2], p[3]); pw.z = pk2(p[4], p[5]); pw.w = pk2(p[6], p[7]);
            const bf16x8 pa = __builtin_bit_cast(bf16x8, pw);
#pragma unroll
            for (int d = 0; d < 4; ++d) {
                const LAS unsigned short* vp = Vt + (16 * d + fr) * 68 + c0 + 4 * fq;
                u64x2 t2; t2.x = *(const LAS u64*)vp; t2.y = *(const LAS u64*)(vp + 16);
                O[g][d] = __builtin_amdgcn_mfma_f32_16x16x32_bf16(pa, __builtin_bit_cast(bf16x8, t2), O[g][d], 0, 0, 0); }
        }
        LDS_WAIT(); asm volatile("" ::: "memory");
    }
#pragma unroll
    for (int g = 0; g < 4; ++g) {
        float l = ls[g]; l += __shfl_xor(l, 16); l += __shfl_xor(l, 32);
#pragma unroll
        for (int e = 0; e < 4; ++e) { const float inv = 1.0f / __shfl(l, 4 * fq + e);
            bf16* op = AO + (size_t)(row0 + 16 * g + 4 * fq + e) * 512 + h * 64 + fr;
#pragma unroll
            for (int d = 0; d < 4; ++d) op[16 * d] = (bf16)f2bf(O[g][d][e] * inv); }
    }
}

__device__ __forceinline__ void swa_unit(cargs_t a, LAS unsigned char* lds, int layer, int unit, int L) {
    const bf16* HP = (const bf16*)(((unsigned char*)a->ws) + WS_HP); bf16* CO = (bf16*)(((unsigned char*)a->ws) + WS_BR) + (size_t)2 * CH * 512;
    int tid_ = threadIdx.x; asm volatile("" : "+v"(tid_)); const int tid = tid_, lane = tid & 63, wv = __builtin_amdgcn_readfirstlane(tid >> 6), q31 = lane & 31, hh = lane >> 5;
    const int g = unit & 1, row0 = (unit >> 1) << 6, seqbase = (row0 / L) * L, t0 = row0 - seqbase;
    const int hq = 4 * g + (wv & 3), qs = wv >> 2;
    LAS unsigned short* Vt = (LAS unsigned short*)lds;
#pragma unroll
    for (int it = 0; it < 5; ++it) { const int idx = tid + 512 * it, kk = idx >> 3, ch = idx & 7; int tok = t0 - 128 + kk; tok = tok < 0 ? 0 : tok; tok = tok > L - 1 ? L - 1 : tok;
        const bf16x8 v8 = *(const bf16x8*)(HP + (size_t)(seqbase + tok) * DIN + OFF_SWV + g * 64 + 8 * ch);
#pragma unroll
        for (int e = 0; e < 8; ++e) Vt[(8 * ch + e) * 324 + kk] = (unsigned short)v8[e]; }
    const int tq = t0 + 32 * qs + q31;
    bf16x8 qf[4];
#pragma unroll
    for (int ks = 0; ks < 4; ++ks) qf[ks] = *(const bf16x8*)(HP + (size_t)(seqbase + tq) * DIN + OFF_SWQ + hq * 64 + 16 * ks + 8 * hh);
    const float slope = __builtin_amdgcn_exp2f(-(float)(hq + 1)), sink = ((const float*)a->in[14])[layer * 8 + hq];
    const int kb0 = t0 + 32 * qs - 128;
    float mx = -3.0e38f;
    for (int kt = 0; kt < 9; ++kt) {
        const int kbase = kb0 + 32 * kt; int tk = kbase + q31; tk = tk < 0 ? 0 : tk; tk = tk > L - 1 ? L - 1 : tk;
        const bf16* kp = HP + (size_t)(seqbase + tk) * DIN + OFF_SWK + g * 64 + 8 * hh;
        f32x16 acc;
#pragma unroll
        for (int e = 0; e < 16; ++e) acc[e] = 0.f;
#pragma unroll
        for (int ks = 0; ks < 4; ++ks) acc = __builtin_amdgcn_mfma_f32_32x32x16_bf16(*(const bf16x8*)(kp + 16 * ks), qf[ks], acc, 0, 0, 0);
#pragma unroll
        for (int e = 0; e < 16; ++e) { const int key = kbase + (e & 3) + 8 * (e >> 2) + 4 * hh; int rel = key - tq; rel = rel < 0 ? -rel : rel;
            const bool ok = (rel <= 128) && (key >= 0) && (key < L);
            const float s = acc[e] * 0.125f - slope * (float)rel; mx = ok ? fmaxf(mx, s) : mx; }
    }
    mx = fmaxf(mx, __shfl_xor(mx, 32));
    const float m = fmaxf(mx, sink);
    __syncthreads();
    float lsum = 0.f; f32x16 O0, O1;
#pragma unroll
    for (int e = 0; e < 16; ++e) { O0[e] = 0.f; O1[e] = 0.f; }
    for (int kt = 0; kt < 9; ++kt) {
        const int kbase = kb0 + 32 * kt; int tk = kbase + q31; tk = tk < 0 ? 0 : tk; tk = tk > L - 1 ? L - 1 : tk;
        const bf16* kp = HP + (size_t)(seqbase + tk) * DIN + OFF_SWK + g * 64 + 8 * hh;
        f32x16 acc;
#pragma unroll
        for (int e = 0; e < 16; ++e) acc[e] = 0.f;
#pragma unroll
        for (int ks = 0; ks < 4; ++ks) acc = __builtin_amdgcn_mfma_f32_32x32x16_bf16(*(const bf16x8*)(kp + 16 * ks), qf[ks], acc, 0, 0, 0);
        float p[16];
#pragma unroll
        for (int e = 0; e < 16; ++e) { const int key = kbase + (e & 3) + 8 * (e >> 2) + 4 * hh; int rel = key - tq; rel = rel < 0 ? -rel : rel;
            const bool ok = (rel <= 128) && (key >= 0) && (key < L);
            const float s = acc[e] * 0.125f - slope * (float)rel;
            p[e] = ok ? __builtin_amdgcn_exp2f((s - m) * 1.4426950408889634f) : 0.f; lsum += p[e]; }
#pragma unroll
        for (int s2 = 0; s2 < 2; ++s2) {
            v4u pw; pw.x = pk2(p[8 * s2], p[8 * s2 + 1]); pw.y = pk2(p[8 * s2 + 2], p[8 * s2 + 3]); pw.z = pk2(p[8 * s2 + 4], p[8 * s2 + 5]); pw.w = pk2(p[8 * s2 + 6], p[8 * s2 + 7]);
            const bf16x8 pa = __builtin_bit_cast(bf16x8, pw);
            const LAS unsigned short* vp = Vt + q31 * 324 + 32 * qs + 32 * kt + 16 * s2 + 4 * hh;
            u64x2 ta, tb; ta.x = *(const LAS u64*)vp; ta.y = *(const LAS u64*)(vp + 8); tb.x = *(const LAS u64*)(vp + 32 * 324); tb.y = *(const LAS u64*)(vp + 32 * 324 + 8);
            O0 = __builtin_amdgcn_mfma_f32_32x32x16_bf16(pa, __builtin_bit_cast(bf16x8, ta), O0, 0, 0, 0);
            O1 = __builtin_amdgcn_mfma_f32_32x32x16_bf16(pa, __builtin_bit_cast(bf16x8, tb), O1, 0, 0, 0); }
    }
    lsum += __shfl_xor(lsum, 32);
    const float denom = lsum + __builtin_amdgcn_exp2f((sink - m) * 1.4426950408889634f);
#pragma unroll
    for (int e = 0; e < 16; ++e) { const int qrow = (e & 3) + 8 * (e >> 2) + 4 * hh; const float inv = 1.0f / __shfl(denom, qrow);
        bf16* op = CO + (size_t)(row0 + 32 * qs + qrow) * 512 + hq * 64 + q31;
        op[0] = (bf16)f2bf(O0[e] * inv); op[32] = (bf16)f2bf(O1[e] * inv); }
    __syncthreads();
}

__device__ __forceinline__ void ln_rows(float* Y, bf16* XBc, const float* gam, const float* bet, int gw, int NGW, int lane) {
    asm volatile("" : "+v"(lane)); asm volatile("" : "+s"(gw));
    f32x4 gv[4], bv[4];
#pragma unroll
    for (int j = 0; j < 4; ++j) { gv[j] = ((const f32x4*)gam)[lane + 64 * j]; bv[j] = ((const f32x4*)bet)[lane + 64 * j]; }
    for (int m = gw; m < CH; m += NGW) {
        f32x4* yr = (f32x4*)(Y + (size_t)m * DM) + lane;
        f32x4 v[4]; float s = 0.f;
#pragma unroll
        for (int j = 0; j < 4; ++j) { v[j] = yr[64 * j]; s += (v[j].x + v[j].y) + (v[j].z + v[j].w); }
        const float mean = wave_sum(s) * (1.f / DM); float s2 = 0.f;
#pragma unroll
        for (int j = 0; j < 4; ++j) { v[j] = v[j] - mean; s2 += (v[j].x * v[j].x + v[j].y * v[j].y) + (v[j].z * v[j].z + v[j].w * v[j].w); }
        const float rstd = 1.f / sqrtf(wave_sum(s2) * (1.f / DM) + LN_EPS);
        u64* o8 = (u64*)(XBc + (size_t)m * DM) + lane;
#pragma unroll
        for (int j = 0; j < 4; ++j) { const f32x4 o = v[j] * rstd * gv[j] + bv[j]; yr[64 * j] = o; o8[64 * j] = (u64)pk2(o.x, o.y) | ((u64)pk2(o.z, o.w) << 32); }
    }
}

__global__ void __launch_bounds__(NWAVES * 64, 2) fwd_kernel(Args args) {
    extern __shared__ __attribute__((aligned(16))) unsigned char lds_raw[];
    LAS unsigned char* lds = (LAS unsigned char*)lds_raw;
    volatile LAS unsigned* MISC = (volatile LAS unsigned*)(lds + LDS_MISC);
    int tid_ = threadIdx.x; asm volatile("" : "+v"(tid_)); const int tid = tid_, lane = tid & 63, wave = __builtin_amdgcn_readfirstlane(tid >> 6);
    const int G = gridDim.x, bx = blockIdx.x;
    const int vcu = (G % 8 == 0) ? (bx % 8) * (G / 8) + bx / 8 : bx;
    const int gw = vcu * NWAVES + wave, NGW = G * NWAVES;
    cargs_t ap = (cargs_t)__builtin_amdgcn_kernarg_segment_ptr();
    unsigned char* ws = ((unsigned char*)ap->ws);
#define RELOAD_ARGS() do { asm volatile("" : "+s"(ap)); ws = ((unsigned char*)ap->ws); } while (0)
    for (int u = tid; u < (LDS_BYTES - LDS_MISC) / 4; u += NWAVES * 64) ((LAS unsigned*)(lds + LDS_MISC))[u] = 0u;
    __syncthreads();
    XcdBarrier bar = xcd_barrier_post((unsigned*)(ws + WS_CTL) + CW_BAR, MISC + 8);
#define GRID_BAR() do { XcdBarrier b2_ = bar; GAS unsigned* gb_ = (GAS unsigned*)bar.bar; asm volatile("" : "+s"(gb_), "+s"(b2_.x)); b2_.bar = (unsigned*)gb_; xcd_barrier(b2_); } while (0)

    p0_prologue(ap, lds, gw, NGW, wave, lane);
    GRID_BAR();

    for (int layer = 0; layer < NLAYER; ++layer) {
        RELOAD_ARGS();
        pf_filters(ap, layer, gw, NGW, lane);
        GRID_BAR();
        for (int u = bx; u < 2048; u += G) { if (u < 1024) spectrum_unit<14>(ap, lds, u >> 9, u & 511); else spectrum_unit<12>(ap, lds, (u - 1024) >> 9, u & 511); }
        GRID_BAR();

        for (int chunk = 0; chunk < NCH; ++chunk) {
            RELOAD_ARGS();
            const int L = chunk < 4 ? L_P : L_S;
            const size_t tok0 = (size_t)chunk * CH;
            bf16* XBc = (bf16*)(ws + WS_XB) + tok0 * DM;
            float* Yc = ((float*)ap->out) + tok0 * DM;
            {
                pg8::Gemm g{XBc, (const bf16*)(ws + WS_WIN) + (size_t)layer * DIN * DM, CH, DIN, DM}; pg8::StaticOrder S; S.init(CH, DIN, G, bx);
                pg8::EpiAct<0> E{(bf16*)(ws + WS_HP), DIN, ((const float*)ap->in[3]) + layer * DIN, OFF_GATE / 256};
                pg8::gemm_phase<pg8::EpiAct<0>, pg8::StaticOrder, true, true>(lds, g, S, E);
            }
            GRID_BAR();
            h1_tiles(ap, lds, layer, L, gw, NGW, wave, lane);
            __syncthreads();
            for (int u = bx; u < CH / 64; u += G) na_unit(ap, lds, layer, u, L);
            __syncthreads();
            for (int u = bx; u < 2 * (CH / 64); u += G) swa_unit(ap, lds, layer, u, L);
            GRID_BAR();
            if (chunk < 4) { for (int u = bx; u < 512; u += G) conv_unit<14>(ap, lds, layer, 0, u); }
            else { for (int u = bx; u < 4 * 512; u += G) conv_unit<12>(ap, lds, layer, u >> 9, u & 511); }
            GRID_BAR();
            h3_tiles(ap, lds, L, gw, NGW, wave, lane);
            GRID_BAR();
            {
                pg8::Gemm g{(const bf16*)(ws + WS_BR), (const bf16*)(ws + WS_WBR) + (size_t)layer * 3 * DM * 512, 3 * CH, 3 * DM, 512}; pg8::MergeOrder S; S.init(CH / 256, G, bx);
                pg8::EpiMerge E{(bf16*)(ws + WS_MG), (const bf16*)(ws + WS_HP) + OFF_GATE, DIN, CH / 256};
                pg8::gemm_phase<pg8::EpiMerge, pg8::MergeOrder, true, true>(lds, g, S, E);
            }
            GRID_BAR();
            {
                const float* xsrc = layer == 0 ? (chunk < 4 ? ((const float*)ap->in[0]) + tok0 * DM : ((const float*)ap->in[1]) + (tok0 - T_PROMPT) * DM) : Yc;
                pg8::Gemm g{(const bf16*)(ws + WS_MG), (const bf16*)(ws + WS_WOUT) + (size_t)layer * DM * DM, CH, DM, DM}; pg8::StaticOrder S; S.init(CH, DM, G, bx);
                pg8::EpiRes E{xsrc, Yc, DM, nullptr, DN_ALPHA};
                pg8::gemm_phase<pg8::EpiRes, pg8::StaticOrder, true, true>(lds, g, S, E);
            }
            GRID_BAR();
            ln_rows(Yc, XBc, ((const float*)ap->in[19]) + layer * DM, ((const float*)ap->in[20]) + layer * DM, gw, NGW, lane);
            GRID_BAR();
            {
                pg8::Gemm g{XBc, (const bf16*)(ws + WS_WUP) + (size_t)layer * DFF * DM, CH, DFF, DM}; pg8::StaticOrder S; S.init(CH, DFF, G, bx);
                pg8::EpiAct<1> E{(bf16*)(ws + WS_HP), DFF, ((const float*)ap->in[22]) + layer * DFF, 0};
                pg8::gemm_phase<pg8::EpiAct<1>, pg8::StaticOrder, true, true>(lds, g, S, E);
            }
            GRID_BAR();
            {
                pg8::Gemm g{(const bf16*)(ws + WS_HP), (const bf16*)(ws + WS_WDN) + (size_t)layer * DM * DFF, CH, DM, DFF}; pg8::StaticOrder S; S.init(CH, DM, G, bx);
                pg8::EpiRes E{Yc, Yc, DM, ((const float*)ap->in[24]) + layer * DM, DN_ALPHA};
                pg8::gemm_phase<pg8::EpiRes, pg8::StaticOrder, true, true>(lds, g, S, E);
            }
            GRID_BAR();
            ln_rows(Yc, XBc, ((const float*)ap->in[25]) + layer * DM, ((const float*)ap->in[26]) + layer * DM, gw, NGW, lane);
            __syncthreads();
        }
    }
}

extern "C" void kernel_launch(void* const* d_in, const int* in_sizes, int n_in, void* d_out, int out_size, void* d_ws, size_t ws_size, hipStream_t stream) {
    static int grid = 0;
    if (grid == 0) {
        if (n_in != 27 || in_sizes[0] != T_PROMPT * DM || out_size != T_ALL * DM || ws_size < WS_END) {
            fprintf(stderr, "kernel_launch: unexpected shapes (n_in %d, in0 %d, out %d, ws %zu); nothing launched\n", n_in, n_in > 0 ? in_sizes[0] : -1, out_size, ws_size); grid = -1; return; }
        int dev = 0, cus = 0, per_cu = 0;
        if (hipGetDevice(&dev) != hipSuccess || hipDeviceGetAttribute(&cus, hipDeviceAttributeMultiprocessorCount, dev) != hipSuccess) { grid = -1; return; }
        if (hipFuncSetAttribute((const void*)fwd_kernel, hipFuncAttributeMaxDynamicSharedMemorySize, LDS_BYTES) != hipSuccess) { fprintf(stderr, "kernel_launch: hipFuncSetAttribute failed\n"); grid = -1; return; }
        if (hipOccupancyMaxActiveBlocksPerMultiprocessor(&per_cu, (const void*)fwd_kernel, NWAVES * 64, LDS_BYTES) != hipSuccess || per_cu < 1)
            fprintf(stderr, "kernel_launch: note: occupancy query reports %d workgroups per CU\n", per_cu);
        (void)hipGetLastError();
        grid = cus;
    }
    if (grid < 0) return;
    if (hipMemsetAsync((char*)d_ws + WS_CTL, 0, CTL_ZERO_BYTES, stream) != hipSuccess) return;
    Args a{};
    for (int i = 0; i < 27; ++i) a.in[i] = (const float*)d_in[i];
    a.out = (float*)d_out; a.ws = (unsigned char*)d_ws;
    hipLaunchKernelGGL(fwd_kernel, dim3(grid), dim3(NWAVES * 64), LDS_BYTES, stream, a);
}
```

```cpp
#include <hip/hip_runtime.h>
#include <cstdio>
#include <cstdint>
#include <type_traits>
namespace pg8 {
#define PG8_LAS __attribute__((address_space(3)))
typedef unsigned short bf16_t;
typedef short bf16x8 __attribute__((ext_vector_type(8)));
typedef float f32x4 __attribute__((ext_vector_type(4)));
typedef unsigned u32x4 __attribute__((ext_vector_type(4)));
constexpr int BM = 256, BK = 64, HALF = 128, HTB = HALF * BK * 2  , STAGE_BYTES = 8 * HTB, NXCD = 8, WGM = 8;

__host__ __device__ __forceinline__ int lds_byte(int r, int c) { const int st = (r >> 4) * 2 + (c >> 5), rr = r & 15, cc = c & 31, ob = rr * 64 + cc * 2; return st * 1024 + (ob ^ (((ob >> 9) & 1) << 5)); }
__host__ __device__ __forceinline__ void stage_rc(int b, int& R, int& C) { const int st = b / 1024, sb = b % 1024, swz = sb ^ (((sb >> 9) & 1) << 5); R = (st >> 1) * 16 + swz / 64; C = (st & 1) * 32 + (swz % 64) / 2; }
__host__ __device__ __forceinline__ int perm32(int rho) { const int n = rho >> 4, i = rho & 15; return 8 * (i >> 2) + 4 * n + (i & 3); }

struct Unit { int pm, pn; };
struct Gemm { const bf16_t* A; const bf16_t* Bt; int M, N, K; };

struct StaticOrder {
    int nM, nN, nwg, G, c;
    __host__ __device__ void init(int M, int N, int G_, int c_) { nM = M / BM; nN = N / BM; nwg = nM * nN; G = G_; c = c_; }
    __host__ __device__ bool next(int i, Unit& u) const {
        const long L = (long)i * G + c; if (L >= nwg) return false;
        int wgid = (int)L; { const int q = nwg / NXCD, r = nwg % NXCD, xcd = wgid % NXCD, off = wgid / NXCD; wgid = (xcd < r ? xcd * (q + 1) : r * (q + 1) + (xcd - r) * q) + off; }
        const int nig = WGM * nN, gid = wgid / nig, fm = gid * WGM, gsz = (nM - fm) < WGM ? (nM - fm) : WGM;
        u.pm = fm + ((wgid % nig) % gsz); u.pn = (wgid % nig) / gsz; return true;
    }
    __device__ __forceinline__ void a_ready(const Unit&) const {}
    __device__ __forceinline__ void done(const Unit&) const {}
};

__device__ __forceinline__ unsigned cvt_pk_bf16(float lo, float hi) { unsigned r; asm volatile("v_cvt_pk_bf16_f32 %0, %1, %2" : "=v"(r) : "v"(lo), "v"(hi)); return r; }
typedef float f32x2 __attribute__((ext_vector_type(2)));

__device__ __forceinline__ float sigmoid_f(float v) { return __builtin_amdgcn_rcpf(1.0f + __builtin_amdgcn_exp2f(-1.4426950408889634f * v)); }

template <int MODE> struct EpiAct {
    static constexpr bool PERM = true, AFTER_DRAIN = false;
    bf16_t* O; int ldc; const float* bias; int gate_pn0;
    __device__ __forceinline__ bool zero_after(const Unit&) const { return true; }
    __device__ __forceinline__ void operator()(f32x4 (&acc)[2][2][4][2], const Unit& u, int wr, int wc, int fr, int fq) const {
        const int row0 = u.pm * BM + wr * 64 + fr, col0 = u.pn * BM + wc * 32 + 8 * fq;
        const bool gate = (MODE == 0) && (u.pn >= gate_pn0);
        f32x4 bv[2][2];
#pragma unroll
        for (int bj = 0; bj < 2; ++bj)
#pragma unroll
            for (int n = 0; n < 2; ++n) bv[bj][n] = *(const f32x4*)(bias + col0 + bj * HALF + 4 * n);
#pragma unroll
        for (int ai = 0; ai < 2; ++ai)
#pragma unroll
            for (int m = 0; m < 4; ++m) { bf16_t* rowp = O + (size_t)(row0 + ai * HALF + m * 16) * ldc + col0;
#pragma unroll
                for (int bj = 0; bj < 2; ++bj) { f32x4 v0 = acc[ai][bj][m][0] + bv[bj][0], v1 = acc[ai][bj][m][1] + bv[bj][1];
                    if (MODE == 1) {
#pragma unroll
                        for (int e = 0; e < 4; ++e) { const float a0 = fmaxf(v0[e], 0.f), a1 = fmaxf(v1[e], 0.f); v0[e] = a0 * a0; v1[e] = a1 * a1; }
                    } else if (gate) {
#pragma unroll
                        for (int e = 0; e < 4; ++e) { v0[e] = sigmoid_f(v0[e]); v1[e] = sigmoid_f(v1[e]); }
                    }
                    u32x4 w; w.x = cvt_pk_bf16(v0[0], v0[1]); w.y = cvt_pk_bf16(v0[2], v0[3]); w.z = cvt_pk_bf16(v1[0], v1[1]); w.w = cvt_pk_bf16(v1[2], v1[3]);
                    *(u32x4*)(rowp + bj * HALF) = w; } }
    }
};

struct EpiRes {
    static constexpr bool PERM = false, AFTER_DRAIN = false;
    const float* X; float* out; int ldc; const float* bias; float alpha;
    __device__ __forceinline__ bool zero_after(const Unit&) const { return true; }
    __device__ __forceinline__ void operator()(f32x4 (&acc)[2][2][4][2], const Unit& u, int wr, int wc, int fr, int fq) const {
        const int row0 = u.pm * BM + wr * 64 + fr, col0 = u.pn * BM + wc * 32 + 4 * fq;
        f32x4 bv[2][2];
#pragma unroll
        for (int bj = 0; bj < 2; ++bj)
#pragma unroll
            for (int n = 0; n < 2; ++n) bv[bj][n] = bias ? *(const f32x4*)(bias + col0 + bj * HALF + n * 16) : (f32x4){0.f, 0.f, 0.f, 0.f};
#pragma unroll
        for (int ai = 0; ai < 2; ++ai)
#pragma unroll
            for (int m = 0; m < 4; ++m) { const size_t off = (size_t)(row0 + ai * HALF + m * 16) * ldc + col0;
#pragma unroll
                for (int bj = 0; bj < 2; ++bj)
#pragma unroll
                    for (int n = 0; n < 2; ++n) { const f32x4 x = *(const f32x4*)(X + off + bj * HALF + n * 16);
                        *(f32x4*)(out + off + bj * HALF + n * 16) = x * alpha + acc[ai][bj][m][n] + bv[bj][n]; }
                asm volatile("" ::: "memory"); }
    }
};

__device__ __forceinline__ float bf_lo(unsigned w) { return __uint_as_float(w << 16); }
__device__ __forceinline__ float bf_hi(unsigned w) { return __uint_as_float(w & 0xffff0000u); }
struct EpiMerge {
    static constexpr bool PERM = true, AFTER_DRAIN = false;
    bf16_t* O; const bf16_t* G; int ldg; int npm;
    __device__ __forceinline__ bool zero_after(const Unit& u) const { return (u.pn >> 2) == 2; }
    __device__ __forceinline__ void operator()(f32x4 (&acc)[2][2][4][2], const Unit& u, int wr, int wc, int fr, int fq) const {
        const int br = u.pn >> 2, pn = u.pn & 3, pm = u.pm - br * npm;
        const int row0 = pm * BM + wr * 64 + fr, col0 = pn * BM + wc * 32 + 8 * fq;
#pragma unroll
        for (int ai = 0; ai < 2; ++ai)
#pragma unroll
            for (int m = 0; m < 4; ++m) { const int row = row0 + ai * HALF + m * 16;
#pragma unroll
                for (int bj = 0; bj < 2; ++bj) { const int col = col0 + bj * HALF;
                    const u32x4 gc = *(const u32x4*)(G + (size_t)row * ldg + br * 1024 + col);
                    float f[8];
                    f[0] = bf_lo(gc.x); f[1] = bf_hi(gc.x); f[2] = bf_lo(gc.y); f[3] = bf_hi(gc.y); f[4] = bf_lo(gc.z); f[5] = bf_hi(gc.z); f[6] = bf_lo(gc.w); f[7] = bf_hi(gc.w);
#pragma unroll
                    for (int e = 0; e < 8; ++e) f[e] = fmaxf(f[e], 1e-30f);
                    if (br < 2) { const u32x4 gn = *(const u32x4*)(G + (size_t)row * ldg + (br + 1) * 1024 + col);
                        float d[8];
                        d[0] = bf_lo(gn.x); d[1] = bf_hi(gn.x); d[2] = bf_lo(gn.y); d[3] = bf_hi(gn.y); d[4] = bf_lo(gn.z); d[5] = bf_hi(gn.z); d[6] = bf_lo(gn.w); d[7] = bf_hi(gn.w);
#pragma unroll
                        for (int e = 0; e < 8; ++e) f[e] = f[e] * __builtin_amdgcn_rcpf(fmaxf(d[e], 1e-30f)); }
                    f32x4 v0 = acc[ai][bj][m][0], v1 = acc[ai][bj][m][1];
#pragma unroll
                    for (int e = 0; e < 4; ++e) { v0[e] *= f[e]; v1[e] *= f[4 + e]; }
                    acc[ai][bj][m][0] = v0; acc[ai][bj][m][1] = v1;
                    if (br == 2) { u32x4 w; w.x = cvt_pk_bf16(v0[0], v0[1]); w.y = cvt_pk_bf16(v0[2], v0[3]); w.z = cvt_pk_bf16(v1[0], v1[1]); w.w = cvt_pk_bf16(v1[2], v1[3]);
                        *(u32x4*)(O + (size_t)row * 1024 + col) = w; } }
                asm volatile("" ::: "memory"); }
    }
};
struct MergeOrder {
    int ntiles, G, c, npm;
    __device__ __forceinline__ void init(int npm_, int G_, int c_) { npm = npm_; ntiles = npm_ * 4; G = G_; c = c_; }
    __device__ __forceinline__ bool next(int i, Unit& u) const {
        const int tile = (i / 3) * G + c, br = i % 3; if (tile >= ntiles) return false;
        u.pm = br * npm + (tile >> 2); u.pn = br * 4 + (tile & 3); return true;
    }
    __device__ __forceinline__ void a_ready(const Unit&) const {}
    __device__ __forceinline__ void done(const Unit&) const {}
};
template <class Epi, class Sched, bool ALIGN_EPI = false, bool SP2 = false>
__device__ __forceinline__ void gemm_phase(PG8_LAS unsigned char* lds, const Gemm g, const Sched& S, const Epi& E) {
    int tid_l = threadIdx.x; asm volatile("" : "+v"(tid_l)); const int tid = tid_l, wid = __builtin_amdgcn_readfirstlane(tid >> 6), lane = tid & 63, wr = wid >> 2, wc = wid & 3, fr = lane & 15, fq = lane >> 4;
    const int K = g.K, nt = K / BK;
    unsigned voffA[2], voffB[2];
#pragma unroll
    for (int i = 0; i < 2; ++i) { int R, C; stage_rc(tid * 16 + i * 8192, R, C); const int Rb = Epi::PERM ? ((R & ~31) + perm32(R & 31)) : R;
        voffA[i] = (unsigned)(R * K + C) * 2u; voffB[i] = (unsigned)(Rb * K + C) * 2u; }
    const size_t kstep = (size_t)(BK * 2);
    const size_t hstep = (size_t)HALF * K * 2;
    const size_t tstep = 2 * hstep;
    const unsigned ldsw = (unsigned)wid * 1024u;
    const int aoff = lds_byte(wr * 64 + fr, fq * 8), boff = lds_byte(wc * 32 + fr, fq * 8);
#define PG8_SA(b, h) (((b) * 2 + (h)) * HTB)
#define PG8_SB(b, h) ((4 + (b) * 2 + (h)) * HTB)
#define PG8_STAGE(bufoff, gbase, voff) do { _Pragma("unroll") for (int _i = 0; _i < 2; ++_i) \
        __builtin_amdgcn_global_load_lds((const unsigned*)((const char*)(gbase) + (voff)[_i]), (PG8_LAS unsigned*)(lds + (bufoff) + ldsw + _i * 8192), 16, 0, 0); } while (0)
#define PG8_LDA(dst, b, h) do { _Pragma("unroll") for (int m = 0; m < 4; ++m) _Pragma("unroll") for (int k = 0; k < 2; ++k) dst[m][k] = *(const PG8_LAS bf16x8*)(lds + PG8_SA(b, h) + aoff + m * 2048 + k * 1024); } while (0)
#define PG8_LDB(dst, b, h) do { _Pragma("unroll") for (int n = 0; n < 2; ++n) _Pragma("unroll") for (int k = 0; k < 2; ++k) dst[n][k] = *(const PG8_LAS bf16x8*)(lds + PG8_SB(b, h) + boff + n * 2048 + k * 1024); } while (0)
#define PG8_MMA(ai, bj, At, Bt) do { __builtin_amdgcn_s_setprio(1); _Pragma("unroll") for (int m = 0; m < 4; ++m) _Pragma("unroll") for (int n = 0; n < 2; ++n) _Pragma("unroll") for (int k = 0; k < 2; ++k) \
        acc[ai][bj][m][n] = __builtin_amdgcn_mfma_f32_16x16x32_bf16(Bt[n][k], At[m][k], acc[ai][bj][m][n], 0, 0, 0); __builtin_amdgcn_s_setprio(0); } while (0)
#define PG8_WAIT_V(n) asm volatile("s_waitcnt vmcnt(" #n ")" ::: "memory")
#define PG8_WAIT_L(n) asm volatile("s_waitcnt lgkmcnt(" #n ")" ::: "memory")
#define PG8_BAR __builtin_amdgcn_s_barrier()
#define PG8_SCHED __builtin_amdgcn_sched_barrier(0)
    Unit cur, nxt; int ui = 0;
    if (!S.next(0, cur)) return;
    f32x4 acc[2][2][4][2];
#pragma unroll
    for (int a = 0; a < 2; ++a)
#pragma unroll
        for (int b = 0; b < 2; ++b)
#pragma unroll
            for (int m = 0; m < 4; ++m)
#pragma unroll
                for (int n = 0; n < 2; ++n) acc[a][b][m][n] = (f32x4){0.f, 0.f, 0.f, 0.f};
    bf16x8 At[4][2], B0[2][2], B1[2][2];
    const char* cA = (const char*)g.A + (size_t)cur.pm * tstep; const char* cB = (const char*)g.Bt + (size_t)cur.pn * tstep;
    S.a_ready(cur);
    if constexpr (SP2) {
        PG8_STAGE(PG8_SB(0, 0), cB, voffB); PG8_STAGE(PG8_SB(0, 1), cB + hstep, voffB); PG8_STAGE(PG8_SA(0, 0), cA, voffA); PG8_STAGE(PG8_SA(0, 1), cA + hstep, voffA);
        if (wr == 1) PG8_BAR;
        PG8_WAIT_V(2); PG8_BAR;
        PG8_STAGE(PG8_SB(1, 0), cB + kstep, voffB); PG8_STAGE(PG8_SA(1, 0), cA + kstep, voffA); PG8_STAGE(PG8_SB(1, 1), cB + hstep + kstep, voffB);
        PG8_WAIT_V(6); PG8_BAR;
    } else {
        PG8_STAGE(PG8_SB(0, 0), cB, voffB); PG8_STAGE(PG8_SA(0, 0), cA, voffA); PG8_STAGE(PG8_SB(0, 1), cB + hstep, voffB); PG8_STAGE(PG8_SA(0, 1), cA + hstep, voffA);
        if (wr == 1) PG8_BAR;
        PG8_WAIT_V(4); PG8_BAR;
        PG8_STAGE(PG8_SB(1, 0), cB + kstep, voffB); PG8_STAGE(PG8_SA(1, 0), cA + kstep, voffA); PG8_STAGE(PG8_SB(1, 1), cB + hstep + kstep, voffB);
        PG8_WAIT_V(6); PG8_BAR;
    }
    for (;;) {
        const bool has_next = S.next(ui + 1, nxt);
        const char* nA = has_next ? (const char*)g.A + (size_t)nxt.pm * tstep : cA; const char* nB = has_next ? (const char*)g.Bt + (size_t)nxt.pn * tstep : cB;
        for (int t = 0; t < nt; t += 2) {
            const bool last = (t == nt - 2);
            const char* a1 = cA + (size_t)(t + 1) * kstep;
            const char* a2 = last ? nA : cA + (size_t)(t + 2) * kstep; const char* b2 = last ? nB : cB + (size_t)(t + 2) * kstep;
            const char* a3 = a2 + kstep; const char* b3 = b2 + kstep;
            if (last && has_next) S.a_ready(nxt);
            if constexpr (SP2) {
            PG8_LDB(B0, 0, 0); PG8_LDB(B1, 0, 1); PG8_SCHED; PG8_LDA(At, 0, 0); PG8_STAGE(PG8_SA(1, 1), a1 + hstep, voffA);
            PG8_WAIT_V(8); PG8_WAIT_L(0); PG8_BAR; PG8_MMA(0, 0, At, B0); PG8_MMA(0, 1, At, B1); PG8_BAR; PG8_SCHED;
            PG8_LDA(At, 0, 1); PG8_STAGE(PG8_SB(0, 0), b2, voffB); PG8_STAGE(PG8_SB(0, 1), b2 + hstep, voffB); PG8_STAGE(PG8_SA(0, 0), a2, voffA);
            PG8_WAIT_V(8); PG8_WAIT_L(0); PG8_BAR; PG8_MMA(1, 0, At, B0); PG8_MMA(1, 1, At, B1); PG8_BAR; PG8_SCHED;
            PG8_LDB(B0, 1, 0); PG8_LDB(B1, 1, 1); PG8_SCHED; PG8_LDA(At, 1, 0); PG8_STAGE(PG8_SA(0, 1), a2 + hstep, voffA);
            PG8_WAIT_V(8); PG8_WAIT_L(0); PG8_BAR; PG8_MMA(0, 0, At, B0); PG8_MMA(0, 1, At, B1); PG8_BAR; PG8_SCHED;
            PG8_LDA(At, 1, 1); PG8_STAGE(PG8_SB(1, 0), b3, voffB); PG8_STAGE(PG8_SB(1, 1), b3 + hstep, voffB); PG8_STAGE(PG8_SA(1, 0), a3, voffA);
            PG8_WAIT_V(8); PG8_WAIT_L(0); PG8_BAR; PG8_MMA(1, 0, At, B0); PG8_MMA(1, 1, At, B1); PG8_BAR; PG8_SCHED;
            } else {
            PG8_LDB(B0, 0, 0); PG8_SCHED; PG8_LDA(At, 0, 0); PG8_STAGE(PG8_SA(1, 1), a1 + hstep, voffA);
            PG8_WAIT_L(8); PG8_BAR; PG8_WAIT_L(0); PG8_MMA(0, 0, At, B0); PG8_BAR; PG8_SCHED;
            PG8_LDB(B1, 0, 1); PG8_STAGE(PG8_SB(0, 0), b2, voffB);
            PG8_BAR; PG8_WAIT_L(0); PG8_MMA(0, 1, At, B1); PG8_BAR;
            PG8_LDA(At, 0, 1); PG8_STAGE(PG8_SA(0, 0), a2, voffA);
            PG8_BAR; PG8_WAIT_L(0); PG8_MMA(1, 0, At, B0); PG8_BAR; PG8_SCHED;
            PG8_STAGE(PG8_SB(0, 1), b2 + hstep, voffB);
            PG8_WAIT_V(6); PG8_BAR; PG8_MMA(1, 1, At, B1); PG8_BAR;
            PG8_LDB(B0, 1, 0); PG8_SCHED; PG8_LDA(At, 1, 0); PG8_STAGE(PG8_SA(0, 1), a2 + hstep, voffA);
            PG8_WAIT_L(8); PG8_BAR; PG8_WAIT_L(0); PG8_MMA(0, 0, At, B0); PG8_BAR; PG8_SCHED;
            PG8_LDB(B1, 1, 1); PG8_STAGE(PG8_SB(1, 0), b3, voffB);
            PG8_BAR; PG8_WAIT_L(0); PG8_MMA(0, 1, At, B1); PG8_BAR;
            PG8_LDA(At, 1, 1); PG8_STAGE(PG8_SA(1, 0), a3, voffA);
            PG8_BAR; PG8_WAIT_L(0); PG8_MMA(1, 0, At, B0); PG8_BAR; PG8_SCHED;
            PG8_STAGE(PG8_SB(1, 1), b3 + hstep, voffB);
            PG8_WAIT_V(6); PG8_BAR; PG8_MMA(1, 1, At, B1); PG8_BAR;
            }
        }
        if constexpr (ALIGN_EPI) { if (wr == 0) PG8_BAR; }
        if constexpr (!Epi::AFTER_DRAIN) { E(acc, cur, wr, wc, fr, fq); S.done(cur); }
        if (!has_next) break;
        if (E.zero_after(cur)) {
#pragma unroll
        for (int a = 0; a < 2; ++a)
#pragma unroll
            for (int b = 0; b < 2; ++b)
#pragma unroll
                for (int m = 0; m < 4; ++m)
#pragma unroll
                    for (int n = 0; n < 2; ++n) acc[a][b][m][n] = (f32x4){0.f, 0.f, 0.f, 0.f};
        }
        cur = nxt; cA = nA; cB = nB; ++ui;
        if constexpr (ALIGN_EPI) { if (wr == 1) PG8_BAR; }
    }
    PG8_WAIT_V(0);
    if constexpr (!ALIGN_EPI) { if (wr == 0) PG8_BAR; }
    PG8_BAR;
    if constexpr (Epi::AFTER_DRAIN) { E.fused(acc, cur, wr, wc, fr, fq, lds, wid, lane); S.done(cur); }
#undef PG8_SA
#undef PG8_SB
#undef PG8_STAGE
#undef PG8_LDA
#undef PG8_LDB
#undef PG8_MMA
#undef PG8_WAIT_V
#undef PG8_WAIT_L
#undef PG8_BAR
#undef PG8_SCHED
}
}
#define GAS __attribute__((address_space(1)))
#define LAS __attribute__((address_space(3)))
typedef unsigned short bf16;
typedef unsigned v4u __attribute__((ext_vector_type(4)));
typedef float f32x4 __attribute__((ext_vector_type(4)));
typedef short bf16x8 __attribute__((ext_vector_type(8)));
typedef GAS unsigned gu32;
typedef GAS unsigned long long gu64;
#define RLX_AGENT __ATOMIC_RELAXED, __HIP_MEMORY_SCOPE_AGENT
#define LDS_WAIT() asm volatile("s_waitcnt lgkmcnt(0)" ::: "memory")
#define VM_WAIT() asm volatile("s_waitcnt vmcnt(0)" ::: "memory")
__device__ __forceinline__ unsigned long long rt() { return __builtin_amdgcn_s_memrealtime(); }
__device__ __forceinline__ unsigned f2bf(float f) { unsigned u = __builtin_bit_cast(unsigned, f); return (u + 0x7fffu + ((u >> 16) & 1u)) >> 16; }
__device__ __forceinline__ unsigned pk2(float lo, float hi) { return f2bf(lo) | (f2bf(hi) << 16); }
#define XB_TMO      128
#define XB_XCNT(j)  (256  + 64 * (j))
#define XB_XSUB(j)  (1280 + 64 * (j))
#define XB_XGEN(j)  (2304 + 64 * (j))
#define XB_TOP      3328
#define XB_TOPGEN   3392
#define XCD_BAR_WORDS 3456
#define XB_SPIN_CAP (1u << 20)

__device__ __forceinline__ unsigned xb_ld(unsigned* p)              { return __hip_atomic_load(p, __ATOMIC_RELAXED, __HIP_MEMORY_SCOPE_AGENT); }
__device__ __forceinline__ unsigned xb_add(unsigned* p, unsigned v) { return __hip_atomic_fetch_add(p, v, __ATOMIC_RELAXED, __HIP_MEMORY_SCOPE_AGENT); }
__device__ __forceinline__ unsigned xb_xcc_id() { return (unsigned)__builtin_amdgcn_s_getreg((3 << 11) | 20) & 0xFu; }
#define XB_SPIN(cond, bar) do { unsigned _sp = 0; while (cond) { __builtin_amdgcn_s_sleep(1); \
    if ((++_sp & 255u) == 0u) { if (xb_ld(&(bar)[XB_TMO])) break; if (_sp > XB_SPIN_CAP) { atomicAdd(&(bar)[XB_TMO], 1u); break; } } } } while (0)

struct XcdBarrier {
    unsigned* bar; unsigned x;
    volatile LAS unsigned* st;
};

__device__ __forceinline__ XcdBarrier xcd_barrier_post(unsigned* bar, volatile LAS unsigned* st) {
    XcdBarrier b; b.bar = bar; b.x = xb_xcc_id(); b.st = st;
    if (threadIdx.x == 0) (void)xb_add(&bar[XB_XCNT(b.x)], 1u);
    return b;
}
__device__ __forceinline__ void xcd_barrier_complete(unsigned* bar, unsigned x, unsigned& nloc, unsigned& nx) {
    const unsigned G = gridDim.x * gridDim.y * gridDim.z;
    unsigned sum, cnt, mine, sp = 0u;
    for (;;) {
        sum = 0u; cnt = 0u; mine = 0u;
#pragma unroll
        for (unsigned j = 0; j < 16; ++j) { const unsigned c = xb_ld(&bar[XB_XCNT(j)]); sum += c; cnt += (c > 0u) ? 1u : 0u; mine = (j == x) ? c : mine; }
        if (sum == G) break;
        __builtin_amdgcn_s_sleep(1);
        if ((++sp & 255u) == 0u) { if (xb_ld(&bar[XB_TMO])) break; if (sp > XB_SPIN_CAP) { atomicAdd(&bar[XB_TMO], 1u); break; } }
    }
    nloc = mine > 0u ? mine : 1u; nx = cnt > 0u ? cnt : 1u;
}

__device__ __forceinline__ void xcd_barrier(const XcdBarrier& b) {
    asm volatile("s_waitcnt vmcnt(0)" ::: "memory");
    __syncthreads();
    if (threadIdx.x == 0) {
        unsigned* bar = b.bar;
        __builtin_amdgcn_s_waitcnt(0);
        unsigned nloc = b.st[0], nx = b.st[1];
        if (nloc == 0u) { xcd_barrier_complete(bar, b.x, nloc, nx); b.st[0] = nloc; b.st[1] = nx; }
        const unsigned old = xb_add(&bar[XB_XSUB(b.x)], 1u);
        const unsigned gen = old / nloc;
        if (old + 1u == (gen + 1u) * nloc) {
            __builtin_amdgcn_fence(__ATOMIC_RELEASE, "agent");
            asm volatile("s_waitcnt vmcnt(0)" ::: "memory");
            const unsigned og = xb_add(&bar[XB_TOP], 1u);
            const unsigned tg = og / nx;
            if (og + 1u == (tg + 1u) * nx) xb_add(&bar[XB_TOPGEN], 1u);
            else XB_SPIN(xb_ld(&bar[XB_TOPGEN]) == tg, bar);
            __builtin_amdgcn_fence(__ATOMIC_ACQUIRE, "agent");
            xb_add(&bar[XB_XGEN(b.x)], 1u);
            asm volatile("s_waitcnt vmcnt(0)" ::: "memory");
        } else {
            XB_SPIN(xb_ld(&bar[XB_XGEN(b.x)]) == gen, bar);
            __builtin_amdgcn_fence(__ATOMIC_ACQUIRE, "agent");
            asm volatile("s_waitcnt vmcnt(0)" ::: "memory");
        }
    }
    __syncthreads();
}
namespace hy {
typedef float f2 __attribute__((ext_vector_type(2)));
#ifdef CPU_EMU
#define HY_DEV
#define HY_LAS
static inline float cos2pi(float f) { return (float)cos(6.283185307179586 * (double)f); }
static inline float sin2pi(float f) { return (float)sin(6.283185307179586 * (double)f); }
#else
#define HY_DEV __device__ __forceinline__
#define HY_LAS __attribute__((address_space(3)))
HY_DEV float cos2pi(float f) { return __builtin_amdgcn_cosf(f); }
HY_DEV float sin2pi(float f) { return __builtin_amdgcn_sinf(f); }
#endif
typedef HY_LAS f2* ldsf2;

constexpr float FC32[16] = {1.0f, 0.98078528040323043f, 0.92387953251128674f, 0.83146961230254524f, 0.70710678118654752f, 0.55557023301960222f, 0.38268343236508977f, 0.19509032201612825f,
                            0.0f, -0.19509032201612825f, -0.38268343236508977f, -0.55557023301960222f, -0.70710678118654752f, -0.83146961230254524f, -0.92387953251128674f, -0.98078528040323043f};
constexpr float FS32[16] = {0.0f, 0.19509032201612825f, 0.38268343236508977f, 0.55557023301960222f, 0.70710678118654752f, 0.83146961230254524f, 0.92387953251128674f, 0.98078528040323043f,
                            1.0f, 0.98078528040323043f, 0.92387953251128674f, 0.83146961230254524f, 0.70710678118654752f, 0.55557023301960222f, 0.38268343236508977f, 0.19509032201612825f};

template <int R> struct Log2 { static constexpr int v = 1 + Log2<R / 2>::v; };
template <> struct Log2<1> { static constexpr int v = 0; };
template <int R> HY_DEV constexpr int brev(int r) { int o = 0; for (int b = 0; b < Log2<R>::v; ++b) o |= ((r >> b) & 1) << (Log2<R>::v - 1 - b); return o; }

template <int R> HY_DEV void dft_dif(float (&re)[R], float (&im)[R]) {
#pragma unroll
    for (int st = 0; st < Log2<R>::v; ++st) {
        const int len = R >> st, half = len >> 1, step = 32 / len;
#pragma unroll
        for (int blk = 0; blk < R; blk += len)
#pragma unroll
            for (int j = 0; j < half; ++j) {
                const int i0 = blk + j, i1 = i0 + half;
                const float ar = re[i0], ai = im[i0], br = re[i1], bi = im[i1];
                re[i0] = ar + br; im[i0] = ai + bi;
                const float tr = ar - br, ti = ai - bi;
                if (j == 0) { re[i1] = tr; im[i1] = ti; }
                else if (4 * j == len) { re[i1] = ti; im[i1] = -tr; }
                else { const float c = FC32[j * step], s = FS32[j * step]; re[i1] = tr * c + ti * s; im[i1] = ti * c - tr * s; }
            }
    }
}
template <int R> HY_DEV void dft_dit_inv(float (&re)[R], float (&im)[R]) {
#pragma unroll
    for (int st = Log2<R>::v - 1; st >= 0; --st) {
        const int len = R >> st, half = len >> 1, step = 32 / len;
#pragma unroll
        for (int blk = 0; blk < R; blk += len)
#pragma unroll
            for (int j = 0; j < half; ++j) {
                const int i0 = blk + j, i1 = i0 + half;
                const float ar = re[i0], ai = im[i0], xr = re[i1], xi = im[i1];
                float br, bi;
                if (j == 0) { br = xr; bi = xi; }
                else if (4 * j == len) { br = -xi; bi = xr; }
                else { const float c = FC32[j * step], s = FS32[j * step]; br = xr * c - xi * s; bi = xi * c + xr * s; }
                re[i0] = ar + br; im[i0] = ai + bi; re[i1] = ar - br; im[i1] = ai - bi;
            }
    }
}

struct P16 { static HY_DEV int phys(int i) { return i + (i >> 4) + ((i >> 9) << 4); } static constexpr int SIZE = 16384 + 1024 + 512, SH1 = 4, M2 = -1; };
struct P4  { static HY_DEV int phys(int i) { return i + (i >> 3); } static constexpr int SIZE = 4096 + 512, SH1 = 3, M2 = 0; };

template <int R, int NB, bool INV> HY_DEV void twiddle(float (&re)[R], float (&im)[R], int n2) {
#ifndef CPU_EMU
    asm volatile("" : "+v"(n2));
#endif
#pragma unroll
    for (int r = 1; r < R; ++r) {
        const int k1 = brev<R>(r);
        const float f = (float)(n2 * k1) * (1.0f / (float)NB);
        const float c = cos2pi(f), s = sin2pi(f);
        const float xr = re[r], xi = im[r];
        if (!INV) { re[r] = xr * c + xi * s; im[r] = xi * c - xr * s; }
        else      { re[r] = xr * c - xi * s; im[r] = xi * c + xr * s; }
    }
}
template <int R, int M, class PH> HY_DEV void lds_load(ldsf2 X, int base, float (&re)[R], float (&im)[R]) {
    const int pb = PH::phys(base); constexpr int PS = M + (M >> PH::SH1) + (((M >> 9) << 4) & PH::M2);
#pragma unroll
    for (int r = 0; r < R; ++r) { const f2 v = X[pb + PS * r]; re[r] = v.x; im[r] = v.y; }
}
template <int R, int M, class PH> HY_DEV void lds_store(ldsf2 X, int base, const float (&re)[R], const float (&im)[R]) {
    const int pb = PH::phys(base); constexpr int PS = M + (M >> PH::SH1) + (((M >> 9) << 4) & PH::M2);
#pragma unroll
    for (int r = 0; r < R; ++r) { f2 v; v.x = re[r]; v.y = im[r]; X[pb + PS * r] = v; }
}
template <int R, int LOGM, class PH> HY_DEV void fwd_from_regs(ldsf2 X, int item, float (&re)[R], float (&im)[R]) {
    constexpr int M = 1 << LOGM, NB = R * M;
    const int blk = item >> LOGM, n2 = item & (M - 1), base = blk * NB + n2;
    dft_dif<R>(re, im);
    if (LOGM > 0) twiddle<R, NB, false>(re, im, n2);
    lds_store<R, M, PH>(X, base, re, im);
}
template <int R, int LOGM, class PH> HY_DEV void fwd_pass(ldsf2 X, int item) {
    constexpr int M = 1 << LOGM, NB = R * M;
    const int blk = item >> LOGM, n2 = item & (M - 1), base = blk * NB + n2;
    float re[R], im[R];
    lds_load<R, M, PH>(X, base, re, im);
    fwd_from_regs<R, LOGM, PH>(X, item, re, im);
}
template <int R, int LOGM, class PH> HY_DEV void inv_to_regs(ldsf2 X, int item, float (&re)[R], float (&im)[R]) {
    constexpr int M = 1 << LOGM, NB = R * M;
    const int blk = item >> LOGM, n2 = item & (M - 1), base = blk * NB + n2;
    lds_load<R, M, PH>(X, base, re, im);
    if (LOGM > 0) twiddle<R, NB, true>(re, im, n2);
    dft_dit_inv<R>(re, im);
}
template <int R, int LOGM, class PH> HY_DEV void inv_pass(ldsf2 X, int item) {
    constexpr int M = 1 << LOGM, NB = R * M;
    const int blk = item >> LOGM, n2 = item & (M - 1), base = blk * NB + n2;
    float re[R], im[R];
    inv_to_regs<R, LOGM, PH>(X, item, re, im);
    lds_store<R, M, PH>(X, base, re, im);
}
template <int R, class PH> HY_DEV void mid_pass(ldsf2 X, int item, const f2* kf) {
    float re[R], im[R];
    lds_load<R, 1, PH>(X, item * R, re, im);
    dft_dif<R>(re, im);
    const f2* kp = kf + item * R;
#pragma unroll
    for (int r = 0; r < R; ++r) { const f2 k = kp[r]; const float xr = re[r], xi = im[r]; re[r] = xr * k.x - xi * k.y; im[r] = xr * k.y + xi * k.x; }
    dft_dit_inv<R>(re, im);
    lds_store<R, 1, PH>(X, item * R, re, im);
}
}

constexpr int NWAVES = 8;
constexpr int DM = 1024, DIN = 6912, DFF = 4096, NLAYER = 2;
constexpr int T_PROMPT = 65536, T_ALL = 98304, L_P = 8192, L_S = 2048;
constexpr int CH = 16384, NCH = 6;
constexpr int OFF_NAQ = 0, OFF_NAK = 512, OFF_NAV = 1024, OFF_HY = 1536, OFF_SWQ = 3072, OFF_SWK = 3584, OFF_SWV = 3712, OFF_GATE = 3840;
constexpr float LN_EPS = 1e-5f;
constexpr float DN_ALPHA = 1.4142135623730951f;

constexpr size_t MiB = 1u << 20;
constexpr size_t WS_CTL = 0, CTL_ZERO_BYTES = 65536;
constexpr size_t WS_WIN = 1 * MiB;
constexpr size_t WS_WBR = 28 * MiB;
constexpr size_t WS_WOUT = 34 * MiB;
constexpr size_t WS_WUP = 38 * MiB;
constexpr size_t WS_WDN = 54 * MiB;
constexpr size_t WS_H2 = 70 * MiB;
constexpr size_t WS_FT = 76 * MiB;
constexpr size_t WS_KF = 156 * MiB;
constexpr size_t WS_XB = 316 * MiB;
constexpr size_t WS_HP = 508 * MiB;
constexpr size_t WS_UT = 724 * MiB;
constexpr size_t WS_HBT = 772 * MiB;
constexpr size_t WS_BR = 788 * MiB;
constexpr size_t WS_MG = 836 * MiB;
constexpr size_t WS_END = 868 * MiB;
constexpr int CW_BAR = 4096;

constexpr int LDS_SCRATCH = 143360;
constexpr int LDS_MISC = LDS_SCRATCH;
constexpr int LDS_BYTES = 147456;

struct Args { const float* in[27]; float* out; unsigned char* ws; };
struct ArgsG { GAS const float* in[27]; GAS float* out; GAS unsigned char* ws; };
typedef __attribute__((address_space(4))) const ArgsG* cargs_t;
typedef unsigned long long u64;
typedef u64 u64x2 __attribute__((ext_vector_type(2)));
typedef float f32x16 __attribute__((ext_vector_type(16)));

__device__ __forceinline__ float bf2f(unsigned short b) { return __uint_as_float((unsigned)b << 16); }
__device__ __forceinline__ float wave_sum(float v) {
#pragma unroll
    for (int o = 1; o < 64; o <<= 1) v += __shfl_xor(v, o);
    return v;
}
__device__ __forceinline__ float sin_rev(float r) { r = r - floorf(r); return __builtin_amdgcn_sinf(r); }
__device__ __forceinline__ float cos_rev(float r) { r = r - floorf(r); return __builtin_amdgcn_cosf(r); }
constexpr float INV_2PI = 0.15915494309189535f;

__device__ __forceinline__ void p0_transpose_item(const float* W, int K, int N, bf16* WT, LAS float* scr, int item, int lane) {
    const int nblk = N / 32, kb = item / nblk, nb = item % nblk, k0 = 64 * kb, n0 = 32 * nb;
#pragma unroll 8
    for (int i = 0; i < 32; ++i) { const int kk = 2 * i + (lane >> 5); scr[kk * 33 + (lane & 31)] = W[(size_t)(k0 + kk) * N + n0 + (lane & 31)]; }
    LDS_WAIT(); asm volatile("" ::: "memory");
    const int c = lane & 7;
#pragma unroll
    for (int j = 0; j < 4; ++j) { const int n = (lane >> 3) + 8 * j; const LAS float* s = scr + (8 * c) * 33 + n;
        v4u o; o.x = pk2(s[0 * 33], s[1 * 33]); o.y = pk2(s[2 * 33], s[3 * 33]); o.z = pk2(s[4 * 33], s[5 * 33]); o.w = pk2(s[6 * 33], s[7 * 33]);
        *(v4u*)(WT + (size_t)(n0 + n) * K + k0 + 8 * c) = o; }
    LDS_WAIT(); asm volatile("" ::: "memory");
}
__device__ __forceinline__ void p0_prologue(cargs_t a, LAS unsigned char* lds, int gw, int NGW, int wave, int lane) {
    asm volatile("" : "+v"(lane)); asm volatile("" : "+s"(gw));
    unsigned char* ws = ((unsigned char*)a->ws);
    LAS float* scr = (LAS float*)(lds + wave * 16384);
    constexpr int I_IN = (DM / 64) * (DIN / 32), I_BR = (512 / 64) * (DM / 32), I_OUT = (DM / 64) * (DM / 32), I_UP = (DM / 64) * (DFF / 32), I_DN = (DFF / 64) * (DM / 32);
    constexpr int PER_LAYER = I_IN + 3 * I_BR + I_OUT + I_UP + I_DN;
    for (int it = gw; it < NLAYER * PER_LAYER; it += NGW) {
        const int l = it / PER_LAYER; int r = it % PER_LAYER;
        if (r < I_IN) { p0_transpose_item(((const float*)a->in[2]) + (size_t)l * DM * DIN, DM, DIN, (bf16*)(ws + WS_WIN) + (size_t)l * DIN * DM, scr, r, lane); continue; } r -= I_IN;
        if (r < 3 * I_BR) { const int b = r / I_BR; p0_transpose_item(((const float*)a->in[15 + b]) + (size_t)l * 512 * DM, 512, DM, (bf16*)(ws + WS_WBR) + (size_t)(l * 3 + b) * DM * 512, scr, r % I_BR, lane); continue; } r -= 3 * I_BR;
        if (r < I_OUT) { p0_transpose_item(((const float*)a->in[18]) + (size_t)l * DM * DM, DM, DM, (bf16*)(ws + WS_WOUT) + (size_t)l * DM * DM, scr, r, lane); continue; } r -= I_OUT;
        if (r < I_UP) { p0_transpose_item(((const float*)a->in[21]) + (size_t)l * DM * DFF, DM, DFF, (bf16*)(ws + WS_WUP) + (size_t)l * DFF * DM, scr, r, lane); continue; } r -= I_UP;
        p0_transpose_item(((const float*)a->in[23]) + (size_t)l * DFF * DM, DFF, DM, (bf16*)(ws + WS_WDN) + (size_t)l * DM * DFF, scr, r, lane);
    }
    bf16* XB = (bf16*)(ws + WS_XB);
    for (int m = gw; m < T_ALL; m += NGW) {
        const float* xr = (m < T_PROMPT) ? ((const float*)a->in[0]) + (size_t)m * DM : ((const float*)a->in[1]) + (size_t)(m - T_PROMPT) * DM;
        const f32x4* x4 = (const f32x4*)xr + lane; u64* o8 = (u64*)(XB + (size_t)m * DM) + lane;
#pragma unroll
        for (int j = 0; j < 4; ++j) { const f32x4 v = x4[64 * j]; o8[64 * j] = (u64)pk2(v.x, v.y) | ((u64)pk2(v.z, v.w) << 32); }
    }
    float* H2 = (float*)(ws + WS_H2);
    for (int it = gw; it < NLAYER * (L_P + L_S); it += NGW) {
        const int l = it / (L_P + L_S), rr = it % (L_P + L_S), L = rr < L_P ? L_P : L_S, i = rr < L_P ? rr : rr - L_P;
        const float* w1 = ((const float*)a->in[6]) + l * 33 * 64; const float* b1 = ((const float*)a->in[7]) + l * 64; const float* w2 = ((const float*)a->in[8]) + l * 64 * 64; const float* b2 = ((const float*)a->in[9]) + l * 64; const float* fq = ((const float*)a->in[10]) + l * 64;
        const float t = (float)i / (float)(L - 1);
        const float w = 6.283185307179586f * (float)i / (float)L;
        float pre = b1[lane] + t * w1[lane];
#pragma unroll
        for (int k = 0; k < 16; ++k) { const float band = 1e-4f + (float)k * ((15.0f - 1e-4f) / 15.0f); const float rv = (w * band) * INV_2PI;
            pre += cos_rev(rv) * w1[(1 + k) * 64 + lane] - sin_rev(rv) * w1[(17 + k) * 64 + lane]; }
        const float fr = fq[lane];
        const float h1 = sin_rev(fr * pre * INV_2PI);
        float pre2 = b2[lane];
        for (int mm = 0; mm < 64; ++mm) pre2 += __shfl(h1, mm) * w2[mm * 64 + lane];
        H2[(size_t)it * 64 + lane] = sin_rev(fr * pre2 * INV_2PI);
    }
}

__device__ __forceinline__ void pf_filters(cargs_t a, LAS unsigned char* lds, int layer, int gw, int NGW, int wave, int lane) {
    asm volatile("" : "+v"(lane)); asm volatile("" : "+s"(gw));
    const float* w3 = ((const float*)a->in[11]) + (size_t)layer * 64 * 2048;
    LAS float* wt = (LAS float*)(lds + wave * 17408);
    constexpr int U_P = (L_P / 64) * 32, U_S = (L_S / 64) * 32;
    for (int it = gw; it < U_P + U_S; it += NGW) {
        const bool sm = it >= U_P; const int r = sm ? it - U_P : it, L = sm ? L_S : L_P, tt = r >> 5, jb = r & 31, t = tt * 64 + lane;
        const float* h2 = (const float*)(((unsigned char*)a->ws) + WS_H2) + ((size_t)layer * (L_P + L_S) + (sm ? L_P : 0) + t) * 64;
        float* FT = (float*)(((unsigned char*)a->ws) + WS_FT) + (sm ? (size_t)2048 * L_P : 0);
#pragma unroll 8
        for (int k = 0; k < 64; ++k) wt[lane * 68 + k] = w3[k * 2048 + jb * 64 + lane];
        float h[64];
#pragma unroll
        for (int k = 0; k < 16; ++k) { const f32x4 v = ((const f32x4*)h2)[k]; h[4 * k] = v.x; h[4 * k + 1] = v.y; h[4 * k + 2] = v.z; h[4 * k + 3] = v.w; }
        const float tf = (float)t / (float)(L - 1);
        LDS_WAIT(); asm volatile("" ::: "memory");
        for (int jj = 0; jj < 64; ++jj) {
            const int j = jb * 64 + jj;
            const LAS f32x4* wr = (const LAS f32x4*)(wt + jj * 68);
            float acc0 = 0.f, acc1 = 0.f;
#pragma unroll
            for (int k4 = 0; k4 < 16; ++k4) { const f32x4 w = wr[k4]; acc0 += h[4 * k4] * w.x; acc1 += h[4 * k4 + 1] * w.y; acc0 += h[4 * k4 + 2] * w.z; acc1 += h[4 * k4 + 3] * w.w; }
            const int c = j & 511;
            const float delta = -3.0701134573253944f + (float)c * ((-15.350567286626972f + 3.0701134573253944f) / 511.0f);
            const float win = __builtin_amdgcn_exp2f(-tf * fabsf(delta) * 1.4426950408889634f);
            FT[(size_t)j * L + t] = (acc0 + acc1) * win;
        }
        LDS_WAIT(); asm volatile("" ::: "memory");
    }
}

template <int LOGN> __device__ __forceinline__ void spectrum_unit(cargs_t a, LAS unsigned char* lds, int n, int c) {
    constexpr int N = 1 << LOGN, L = N / 2, R = (LOGN == 14) ? 32 : 8;
    typedef typename std::conditional<LOGN == 14, hy::P16, hy::P4>::type PH;
    int tid = threadIdx.x; asm volatile("" : "+v"(tid));
    hy::ldsf2 X = (hy::ldsf2)lds;
    const float* FT = (const float*)(((unsigned char*)a->ws) + WS_FT) + (LOGN == 14 ? 0 : (size_t)2048 * L_P);
    const float* ff = FT + (size_t)(n * 1024 + c) * L; const float* fb = FT + (size_t)(n * 1024 + 512 + c) * L;
    hy::f2* KF = (hy::f2*)(((unsigned char*)a->ws) + WS_KF) + (LOGN == 14 ? 0 : (size_t)1024 * 16384) + (size_t)(n * 512 + c) * N;
    float re[R], im[R];
#pragma unroll
    for (int n1 = 0; n1 < R; ++n1) { const int t = 512 * n1 + tid; im[n1] = 0.f;
        if (n1 < R / 2) re[n1] = ff[t]; else re[n1] = (t == L) ? 0.f : fb[(t == L) ? 1 : N - t]; }
    hy::fwd_from_regs<R, 9, PH>(X, tid, re, im);
    __syncthreads();
    if (LOGN == 14) { hy::fwd_pass<32, 4, PH>(X, tid); __syncthreads(); hy::fwd_pass<16, 0, PH>(X, tid); hy::fwd_pass<16, 0, PH>(X, tid + 512); }
    else { hy::fwd_pass<8, 6, PH>(X, tid); __syncthreads(); hy::fwd_pass<8, 3, PH>(X, tid); __syncthreads(); hy::fwd_pass<8, 0, PH>(X, tid); }
    __syncthreads();
    const float sc = 1.0f / (float)N;
#pragma unroll 4
    for (int i = tid; i < N; i += 512) { const hy::f2 v = X[PH::phys(i)]; KF[i] = v * sc; }
    __syncthreads();
}

__device__ __forceinline__ void h1_tiles(cargs_t a, LAS unsigned char* lds, int layer, int L, int gw, int NGW, int wave, int lane) {
    asm volatile("" : "+v"(lane)); asm volatile("" : "+s"(gw));
    const bf16* HP = (const bf16*)(((unsigned char*)a->ws) + WS_HP); bf16* UT = (bf16*)(((unsigned char*)a->ws) + WS_UT);
    LAS unsigned char* raw = lds + wave * 16384;
    const float* cw = ((const float*)a->in[4]) + layer * 3 * 1536; const float* cb = ((const float*)a->in[5]) + layer * 1536;
    for (int tile = gw; tile < (CH / 64) * 24; tile += NGW) {
        const int tt = tile / 24, cbk = tile % 24, row0 = tt * 64, seq = row0 / L, t0 = row0 - seq * L;
        const int rr = lane >> 3, ch = lane & 7;
#pragma unroll
        for (int it = 0; it < 9; ++it) { const int lr = it * 8 + rr; const int tq = t0 + lr - 1;
            if (lr < 66) { v4u v = (v4u){0u, 0u, 0u, 0u};
                if (tq >= 0 && tq < L) v = *(const v4u*)(HP + (size_t)(row0 + lr - 1) * DIN + OFF_HY + cbk * 64 + ch * 8);
                *(LAS v4u*)(raw + lr * 128 + ch * 16) = v; } }
        LDS_WAIT(); asm volatile("" ::: "memory");
        const int col = cbk * 64 + lane;
        const float w0 = cw[col], w1 = cw[1536 + col], w2 = cw[2 * 1536 + col], bb = cb[col];
        const LAS unsigned short* rc = (const LAS unsigned short*)raw + lane;
        float xp = bf2f(rc[0]), xc = bf2f(rc[64]);
        bf16* dst = UT + ((size_t)(seq * 1536 + col)) * L + t0;
#pragma unroll
        for (int t8 = 0; t8 < 8; ++t8) { float u[8];
#pragma unroll
            for (int e = 0; e < 8; ++e) { const float xn = bf2f(rc[(t8 * 8 + e + 2) * 64]); u[e] = w0 * xp + w1 * xc + w2 * xn + bb; xp = xc; xc = xn; }
            v4u o; o.x = pk2(u[0], u[1]); o.y = pk2(u[2], u[3]); o.z = pk2(u[4], u[5]); o.w = pk2(u[6], u[7]);
            *(v4u*)(dst + t8 * 8) = o; }
        LDS_WAIT(); asm volatile("" ::: "memory");
    }
}

template <int LOGN> __device__ __forceinline__ void conv_passes(LAS unsigned char* lds, const hy::f2* kf, float (&re)[(LOGN == 14) ? 32 : 8], float (&im)[(LOGN == 14) ? 32 : 8]) {
    constexpr int R = (LOGN == 14) ? 32 : 8;
    typedef typename std::conditional<LOGN == 14, hy::P16, hy::P4>::type PH;
    int tid = threadIdx.x; asm volatile("" : "+v"(tid)); hy::ldsf2 X = (hy::ldsf2)lds;
    hy::fwd_from_regs<R, 9, PH>(X, tid, re, im);
    __syncthreads();
    if (LOGN == 14) {
        hy::fwd_pass<32, 4, PH>(X, tid); __syncthreads();
        hy::mid_pass<16, PH>(X, tid, kf); hy::mid_pass<16, PH>(X, tid + 512, kf); __syncthreads();
        hy::inv_pass<32, 4, PH>(X, tid); __syncthreads();
    } else {
        hy::fwd_pass<8, 6, PH>(X, tid); __syncthreads();
        hy::fwd_pass<8, 3, PH>(X, tid); __syncthreads();
        hy::mid_pass<8, PH>(X, tid, kf); __syncthreads();
        hy::inv_pass<8, 3, PH>(X, tid); __syncthreads();
        hy::inv_pass<8, 6, PH>(X, tid); __syncthreads();
    }
    hy::inv_to_regs<R, 9, PH>(X, tid, re, im);
    __syncthreads();
}
template <int LOGN> __device__ __forceinline__ void conv_unit(cargs_t a, LAS unsigned char* lds, int layer, int pair, int c) {
    constexpr int N = 1 << LOGN, L = N / 2, R = (LOGN == 14) ? 32 : 8, NH = R / 2;
    int tid = threadIdx.x; asm volatile("" : "+v"(tid));
    const bf16* UT = (const bf16*)(((unsigned char*)a->ws) + WS_UT); bf16* HBT = (bf16*)(((unsigned char*)a->ws) + WS_HBT);
    const hy::f2* KF = (const hy::f2*)(((unsigned char*)a->ws) + WS_KF) + (LOGN == 14 ? 0 : (size_t)1024 * 16384);
    const int s0 = 2 * pair, s1 = s0 + 1;
    const bf16* v0 = UT + (size_t)(s0 * 1536 + c) * L; const bf16* v1 = UT + (size_t)(s1 * 1536 + c) * L;
    const float bias0 = ((const float*)a->in[12])[(layer * 2 + 0) * 512 + c], bias1 = ((const float*)a->in[12])[(layer * 2 + 1) * 512 + c];
    float re[R], im[R];
#pragma unroll
    for (int n1 = 0; n1 < R; ++n1) { const int t = 512 * n1 + tid;
        if (n1 < NH) { re[n1] = bf2f(v0[t]); im[n1] = bf2f(v1[t]); } else { re[n1] = 0.f; im[n1] = 0.f; } }
    conv_passes<LOGN>(lds, KF + (size_t)(0 * 512 + c) * N, re, im);
    bf16* z0p = HBT + (size_t)(s0 * 512 + c) * L; bf16* z1p = HBT + (size_t)(s1 * 512 + c) * L;
#pragma unroll
    for (int n1 = 0; n1 < R; ++n1) { const int t = 512 * n1 + tid;
        if (n1 < NH) { const float g0 = bf2f(v0[(size_t)512 * L + t]), g1 = bf2f(v1[(size_t)512 * L + t]);
            const float za = g0 * (re[n1] + bias0 * bf2f(v0[t])), zb = g1 * (im[n1] + bias0 * bf2f(v1[t]));
            z0p[t] = (bf16)f2bf(za); z1p[t] = (bf16)f2bf(zb); re[n1] = za; im[n1] = zb; } else { re[n1] = 0.f; im[n1] = 0.f; } }
    conv_passes<LOGN>(lds, KF + (size_t)(1 * 512 + c) * N, re, im);
#pragma unroll
    for (int n1 = 0; n1 < NH; ++n1) { const int t = 512 * n1 + tid;
        const float g0 = bf2f(v0[(size_t)1024 * L + t]), g1 = bf2f(v1[(size_t)1024 * L + t]);
        const float za = bf2f(z0p[t]), zb = bf2f(z1p[t]);
        z0p[t] = (bf16)f2bf(g0 * (re[n1] + bias1 * za));
        z1p[t] = (bf16)f2bf(g1 * (im[n1] + bias1 * zb)); }
}

__device__ __forceinline__ void h3_tiles(cargs_t a, LAS unsigned char* lds, int L, int gw, int NGW, int wave, int lane) {
    asm volatile("" : "+v"(lane)); asm volatile("" : "+s"(gw));
    const bf16* HBT = (const bf16*)(((unsigned char*)a->ws) + WS_HBT); bf16* B1 = (bf16*)(((unsigned char*)a->ws) + WS_BR) + (size_t)CH * 512;
    LAS unsigned char* tl = lds + wave * 16384;
    for (int tile = gw; tile < (CH / 64) * 8; tile += NGW) {
        const int tt = tile >> 3, cbk = tile & 7, row0 = tt * 64, seq = row0 / L, t0 = row0 - seq * L;
        const bf16* src = HBT + (size_t)(seq * 512 + cbk * 64 + lane) * L + t0;
#pragma unroll
        for (int t8 = 0; t8 < 8; ++t8) { const v4u v = *(const v4u*)(src + t8 * 8);
            const unsigned wv[4] = {v.x, v.y, v.z, v.w};
#pragma unroll
            for (int e = 0; e < 4; ++e) { *(LAS unsigned short*)(tl + (t8 * 8 + 2 * e) * 128 + lane * 2) = (unsigned short)(wv[e] & 0xffffu);
                                          *(LAS unsigned short*)(tl + (t8 * 8 + 2 * e + 1) * 128 + lane * 2) = (unsigned short)(wv[e] >> 16); } }
        LDS_WAIT(); asm volatile("" ::: "memory");
        const int rr = lane >> 3, ch = lane & 7;
#pragma unroll
        for (int it = 0; it < 8; ++it) { const int r = it * 8 + rr; const v4u v = *(const LAS v4u*)(tl + r * 128 + ch * 16);
            *(v4u*)(B1 + (size_t)(row0 + r) * 512 + cbk * 64 + ch * 8) = v; }
        LDS_WAIT(); asm volatile("" ::: "memory");
    }
}

__device__ __forceinline__ void na_unit(cargs_t a, LAS unsigned char* lds, int layer, int unit, int L) {
    const bf16* HP = (const bf16*)(((unsigned char*)a->ws) + WS_HP); bf16* AO = (bf16*)(((unsigned char*)a->ws) + WS_BR);
    int tid_ = threadIdx.x; asm volatile("" : "+v"(tid_)); const int tid = tid_, lane = tid & 63, h = __builtin_amdgcn_readfirstlane(tid >> 6), fr = lane & 15, fq = lane >> 4;
    const int rows = L >> 6, row0 = unit << 6, seqbase = (row0 / L) * L, r = (row0 - seqbase) >> 6;
    int rs = r - 4; rs = rs < 0 ? 0 : rs; rs = rs > rows - 8 ? rows - 8 : rs;
    LAS unsigned short* Vt = (LAS unsigned short*)(lds + h * 16384);
    LAS float* rpbs = (LAS float*)(lds + h * 16384 + 8704);
    const float* rpbg = ((const float*)a->in[13]) + (size_t)(layer * 8 + h) * 465;
    for (int i = lane; i < 465; i += 64) rpbs[i] = rpbg[i];
    bf16x8 qf[4][2];
#pragma unroll
    for (int g = 0; g < 4; ++g)
#pragma unroll
        for (int ks = 0; ks < 2; ++ks) qf[g][ks] = *(const bf16x8*)(HP + (size_t)(row0 + 16 * g + fr) * DIN + OFF_NAQ + h * 64 + 32 * ks + 8 * fq);
    float mx[4] = {-3.0e38f, -3.0e38f, -3.0e38f, -3.0e38f};
    LDS_WAIT(); asm volatile("" ::: "memory");
    for (int i = 0; i < 8; ++i) {
        const bf16* kbase = HP + (size_t)(seqbase + (rs + i) * 64) * DIN + OFF_NAK + h * 64 + 8 * fq;
        const int rbase = (rs + i - r + 7) * 31;
#pragma unroll
        for (int g = 0; g < 4; ++g) {
            const int c0 = (g == 0) ? 0 : (g == 1) ? 8 : (g == 2) ? 24 : 32;
            const int w = 16 * g + fr; int cs = w - 8; cs = cs < 0 ? 0 : cs; cs = cs > 48 ? 48 : cs;
            f32x4 acc0 = (f32x4){0.f, 0.f, 0.f, 0.f}, acc1 = acc0;
#pragma unroll
            for (int ks = 0; ks < 2; ++ks) {
                const bf16x8 k0 = *(const bf16x8*)(kbase + (size_t)(c0 + fr) * DIN + 32 * ks), k1 = *(const bf16x8*)(kbase + (size_t)(c0 + 16 + fr) * DIN + 32 * ks);
                acc0 = __builtin_amdgcn_mfma_f32_16x16x32_bf16(k0, qf[g][ks], acc0, 0, 0, 0); acc1 = __builtin_amdgcn_mfma_f32_16x16x32_bf16(k1, qf[g][ks], acc1, 0, 0, 0); }
#pragma unroll
            for (int e = 0; e < 4; ++e) {
                const int kc0 = c0 + 4 * fq + e, kc1 = kc0 + 16;
                const bool ok0 = (kc0 >= cs) && (kc0 < cs + 16), ok1 = (kc1 >= cs) && (kc1 < cs + 16);
                const float s0 = acc0[e] * 0.125f + rpbs[ok0 ? rbase + kc0 - w + 15 : 0], s1 = acc1[e] * 0.125f + rpbs[ok1 ? rbase + kc1 - w + 15 : 0];
                mx[g] = ok0 ? fmaxf(mx[g], s0) : mx[g]; mx[g] = ok1 ? fmaxf(mx[g], s1) : mx[g]; }
        }
    }
#pragma unroll
    for (int g = 0; g < 4; ++g) { mx[g] = fmaxf(mx[g], __shfl_xor(mx[g], 16)); mx[g] = fmaxf(mx[g], __shfl_xor(mx[g], 32)); }
    float ls[4] = {0.f, 0.f, 0.f, 0.f};
    f32x4 O[4][4];
#pragma unroll
    for (int g = 0; g < 4; ++g)
#pragma unroll
        for (int d = 0; d < 4; ++d) O[g][d] = (f32x4){0.f, 0.f, 0.f, 0.f};
    for (int i = 0; i < 8; ++i) {
        const bf16* kbase = HP + (size_t)(seqbase + (rs + i) * 64) * DIN + OFF_NAK + h * 64 + 8 * fq;
        const bf16* vrow = HP + (size_t)(seqbase + (rs + i) * 64 + lane) * DIN + OFF_NAV + h * 64;
        const int rbase = (rs + i - r + 7) * 31;
#pragma unroll
        for (int it = 0; it < 8; ++it) { const bf16x8 v8 = *(const bf16x8*)(vrow + 8 * it);
#pragma unroll
            for (int e = 0; e < 8; ++e) Vt[(8 * it + e) * 68 + lane] = (unsigned short)v8[e]; }
        LDS_WAIT(); asm volatile("" ::: "memory");
#pragma unroll
        for (int g = 0; g < 4; ++g) {
            const int c0 = (g == 0) ? 0 : (g == 1) ? 8 : (g == 2) ? 24 : 32;
            const int w = 16 * g + fr; int cs = w - 8; cs = cs < 0 ? 0 : cs; cs = cs > 48 ? 48 : cs;
            f32x4 acc0 = (f32x4){0.f, 0.f, 0.f, 0.f}, acc1 = acc0;
#pragma unroll
            for (int ks = 0; ks < 2; ++ks) {
                const bf16x8 k0 = *(const bf16x8*)(kbase + (size_t)(c0 + fr) * DIN + 32 * ks), k1 = *(const bf16x8*)(kbase + (size_t)(c0 + 16 + fr) * DIN + 32 * ks);
                acc0 = __builtin_amdgcn_mfma_f32_16x16x32_bf16(k0, qf[g][ks], acc0, 0, 0, 0); acc1 = __builtin_amdgcn_mfma_f32_16x16x32_bf16(k1, qf[g][ks], acc1, 0, 0, 0); }
            float p[8];
#pragma unroll
            for (int e = 0; e < 4; ++e) {
                const int kc0 = c0 + 4 * fq + e, kc1 = kc0 + 16;
                const bool ok0 = (kc0 >= cs) && (kc0 < cs + 16), ok1 = (kc1 >= cs) && (kc1 < cs + 16);
                const float s0 = acc0[e] * 0.125f + rpbs[ok0 ? rbase + kc0 - w + 15 : 0], s1 = acc1[e] * 0.125f + rpbs[ok1 ? rbase + kc1 - w + 15 : 0];
                p[e] = ok0 ? __builtin_amdgcn_exp2f((s0 - mx[g]) * 1.4426950408889634f) : 0.f;
                p[4 + e] = ok1 ? __builtin_amdgcn_exp2f((s1 - mx[g]) * 1.4426950408889634f) : 0.f;
                ls[g] += p[e] + p[4 + e]; }
            v4u pw; pw.x = pk2(p[0], p[1]); pw.y = pk2(p[2], p[3]); pw.z = pk2(p[4], p[5]); pw.w = pk2(p[6], p[7]);
            const bf16x8 pa = __builtin_bit_cast(bf16x8, pw);
#pragma unroll
            for (int d = 0; d < 4; ++d) {
                const LAS unsigned short* vp = Vt + (16 * d + fr) * 68 + c0 + 4 * fq;
                u64x2 t2; t2.x = *(const LAS u64*)vp; t2.y = *(const LAS u64*)(vp + 16);
                O[g][d] = __builtin_amdgcn_mfma_f32_16x16x32_bf16(pa, __builtin_bit_cast(bf16x8, t2), O[g][d], 0, 0, 0); }
        }
        LDS_WAIT(); asm volatile("" ::: "memory");
    }
#pragma unroll
    for (int g = 0; g < 4; ++g) {
        float l = ls[g]; l += __shfl_xor(l, 16); l += __shfl_xor(l, 32);
#pragma unroll
        for (int e = 0; e < 4; ++e) { const float inv = 1.0f / __shfl(l, 4 * fq + e);
            bf16* op = AO + (size_t)(row0 + 16 * g + 4 * fq + e) * 512 + h * 64 + fr;
#pragma unroll
            for (int d = 0; d < 4; ++d) op[16 * d] = (bf16)f2bf(O[g][d][e] * inv); }
    }
}

__device__ __forceinline__ void swa_unit(cargs_t a, LAS unsigned char* lds, int layer, int unit, int L) {
    const bf16* HP = (const bf16*)(((unsigned char*)a->ws) + WS_HP); bf16* CO = (bf16*)(((unsigned char*)a->ws) + WS_BR) + (size_t)2 * CH * 512;
    int tid_ = threadIdx.x; asm volatile("" : "+v"(tid_)); const int tid = tid_, lane = tid & 63, wv = __builtin_amdgcn_readfirstlane(tid >> 6), q31 = lane & 31, hh = lane >> 5;
    const int g = unit & 1, row0 = (unit >> 1) << 6, seqbase = (row0 / L) * L, t0 = row0 - seqbase;
    const int hq = 4 * g + (wv & 3), qs = wv >> 2;
    LAS unsigned short* Vt = (LAS unsigned short*)lds;
#pragma unroll
    for (int it = 0; it < 5; ++it) { const int idx = tid + 512 * it, kk = idx >> 3, ch = idx & 7; int tok = t0 - 128 + kk; tok = tok < 0 ? 0 : tok; tok = tok > L - 1 ? L - 1 : tok;
        const bf16x8 v8 = *(const bf16x8*)(HP + (size_t)(seqbase + tok) * DIN + OFF_SWV + g * 64 + 8 * ch);
#pragma unroll
        for (int e = 0; e < 8; ++e) Vt[(8 * ch + e) * 324 + kk] = (unsigned short)v8[e]; }
    const int tq = t0 + 32 * qs + q31;
    bf16x8 qf[4];
#pragma unroll
    for (int ks = 0; ks < 4; ++ks) qf[ks] = *(const bf16x8*)(HP + (size_t)(seqbase + tq) * DIN + OFF_SWQ + hq * 64 + 16 * ks + 8 * hh);
    const float slope = __builtin_amdgcn_exp2f(-(float)(hq + 1)), sink = ((const float*)a->in[14])[layer * 8 + hq];
    const int kb0 = t0 + 32 * qs - 128;
    float mx = -3.0e38f;
    for (int kt = 0; kt < 9; ++kt) {
        const int kbase = kb0 + 32 * kt; int tk = kbase + q31; tk = tk < 0 ? 0 : tk; tk = tk > L - 1 ? L - 1 : tk;
        const bf16* kp = HP + (size_t)(seqbase + tk) * DIN + OFF_SWK + g * 64 + 8 * hh;
        f32x16 acc;
#pragma unroll
        for (int e = 0; e < 16; ++e) acc[e] = 0.f;
#pragma unroll
        for (int ks = 0; ks < 4; ++ks) acc = __builtin_amdgcn_mfma_f32_32x32x16_bf16(*(const bf16x8*)(kp + 16 * ks), qf[ks], acc, 0, 0, 0);
#pragma unroll
        for (int e = 0; e < 16; ++e) { const int key = kbase + (e & 3) + 8 * (e >> 2) + 4 * hh; int rel = key - tq; rel = rel < 0 ? -rel : rel;
            const bool ok = (rel <= 128) && (key >= 0) && (key < L);
            const float s = acc[e] * 0.125f - slope * (float)rel; mx = ok ? fmaxf(mx, s) : mx; }
    }
    mx = fmaxf(mx, __shfl_xor(mx, 32));
    const float m = fmaxf(mx, sink);
    __syncthreads();
    float lsum = 0.f; f32x16 O0, O1;
#pragma unroll
    for (int e = 0; e < 16; ++e) { O0[e] = 0.f; O1[e] = 0.f; }
    for (int kt = 0; kt < 9; ++kt) {
        const int kbase = kb0 + 32 * kt; int tk = kbase + q31; tk = tk < 0 ? 0 : tk; tk = tk > L - 1 ? L - 1 : tk;
        const bf16* kp = HP + (size_t)(seqbase + tk) * DIN + OFF_SWK + g * 64 + 8 * hh;
        f32x16 acc;
#pragma unroll
        for (int e = 0; e < 16; ++e) acc[e] = 0.f;
#pragma unroll
        for (int ks = 0; ks < 4; ++ks) acc = __builtin_amdgcn_mfma_f32_32x32x16_bf16(*(const bf16x8*)(kp + 16 * ks), qf[ks], acc, 0, 0, 0);
        float p[16];
#pragma unroll
        for (int e = 0; e < 16; ++e) { const int key = kbase + (e & 3) + 8 * (e >> 2) + 4 * hh; int rel = key - tq; rel = rel < 0 ? -rel : rel;
            const bool ok = (rel <= 128) && (key >= 0) && (key < L);
            const float s = acc[e] * 0.125f - slope * (float)rel;
            p[e] = ok ? __builtin_amdgcn_exp2f((s - m) * 1.4426950408889634f) : 0.f; lsum += p[e]; }
#pragma unroll
        for (int s2 = 0; s2 < 2; ++s2) {
            v4u pw; pw.x = pk2(p[8 * s2], p[8 * s2 + 1]); pw.y = pk2(p[8 * s2 + 2], p[8 * s2 + 3]); pw.z = pk2(p[8 * s2 + 4], p[8 * s2 + 5]); pw.w = pk2(p[8 * s2 + 6], p[8 * s2 + 7]);
            const bf16x8 pa = __builtin_bit_cast(bf16x8, pw);
            const LAS unsigned short* vp = Vt + q31 * 324 + 32 * qs + 32 * kt + 16 * s2 + 4 * hh;
            u64x2 ta, tb; ta.x = *(const LAS u64*)vp; ta.y = *(const LAS u64*)(vp + 8); tb.x = *(const LAS u64*)(vp + 32 * 324); tb.y = *(const LAS u64*)(vp + 32 * 324 + 8);
            O0 = __builtin_amdgcn_mfma_f32_32x32x16_bf16(pa, __builtin_bit_cast(bf16x8, ta), O0, 0, 0, 0);
            O1 = __builtin_amdgcn_mfma_f32_32x32x16_bf16(pa, __builtin_bit_cast(bf16x8, tb), O1, 0, 0, 0); }
    }
    lsum += __shfl_xor(lsum, 32);
    const float denom = lsum + __builtin_amdgcn_exp2f((sink - m) * 1.4426950408889634f);
#pragma unroll
    for (int e = 0; e < 16; ++e) { const int qrow = (e & 3) + 8 * (e >> 2) + 4 * hh; const float inv = 1.0f / __shfl(denom, qrow);
        bf16* op = CO + (size_t)(row0 + 32 * qs + qrow) * 512 + hq * 64 + q31;
        op[0] = (bf16)f2bf(O0[e] * inv); op[32] = (bf16)f2bf(O1[e] * inv); }
    __syncthreads();
}

__device__ __forceinline__ void ln_rows(float* Y, bf16* XBc, const float* gam, const float* bet, int gw, int NGW, int lane) {
    asm volatile("" : "+v"(lane)); asm volatile("" : "+s"(gw));
    f32x4 gv[4], bv[4];
#pragma unroll
    for (int j = 0; j < 4; ++j) { gv[j] = ((const f32x4*)gam)[lane + 64 * j]; bv[j] = ((const f32x4*)bet)[lane + 64 * j]; }
    for (int m = gw; m < CH; m += NGW) {
        f32x4* yr = (f32x4*)(Y + (size_t)m * DM) + lane;
        f32x4 v[4]; float s = 0.f;
#pragma unroll
        for (int j = 0; j < 4; ++j) { v[j] = yr[64 * j]; s += (v[j].x + v[j].y) + (v[j].z + v[j].w); }
        const float mean = wave_sum(s) * (1.f / DM); float s2 = 0.f;
#pragma unroll
        for (int j = 0; j < 4; ++j) { v[j] = v[j] - mean; s2 += (v[j].x * v[j].x + v[j].y * v[j].y) + (v[j].z * v[j].z + v[j].w * v[j].w); }
        const float rstd = 1.f / sqrtf(wave_sum(s2) * (1.f / DM) + LN_EPS);
        u64* o8 = (u64*)(XBc + (size_t)m * DM) + lane;
#pragma unroll
        for (int j = 0; j < 4; ++j) { const f32x4 o = v[j] * rstd * gv[j] + bv[j]; yr[64 * j] = o; o8[64 * j] = (u64)pk2(o.x, o.y) | ((u64)pk2(o.z, o.w) << 32); }
    }
}

__global__ void __launch_bounds__(NWAVES * 64, 2) fwd_kernel(Args args) {
    extern __shared__ __attribute__((aligned(16))) unsigned char lds_raw[];
    LAS unsigned char* lds = (LAS unsigned char*)lds_raw;
    volatile LAS unsigned* MISC = (volatile LAS unsigned*)(lds + LDS_MISC);
    int tid_ = threadIdx.x; asm volatile("" : "+v"(tid_)); const int tid = tid_, lane = tid & 63, wave = __builtin_amdgcn_readfirstlane(tid >> 6);
    const int G = gridDim.x, bx = blockIdx.x;
    const int vcu = (G % 8 == 0) ? (bx % 8) * (G / 8) + bx / 8 : bx;
    const int gw = vcu * NWAVES + wave, NGW = G * NWAVES;
    cargs_t ap = (cargs_t)__builtin_amdgcn_kernarg_segment_ptr();
    unsigned char* ws = ((unsigned char*)ap->ws);
#define RELOAD_ARGS() do { asm volatile("" : "+s"(ap)); ws = ((unsigned char*)ap->ws); } while (0)
    for (int u = tid; u < (LDS_BYTES - LDS_MISC) / 4; u += NWAVES * 64) ((LAS unsigned*)(lds + LDS_MISC))[u] = 0u;
    __syncthreads();
    XcdBarrier bar = xcd_barrier_post((unsigned*)(ws + WS_CTL) + CW_BAR, MISC + 8);
#define GRID_BAR() do { XcdBarrier b2_ = bar; GAS unsigned* gb_ = (GAS unsigned*)bar.bar; asm volatile("" : "+s"(gb_), "+s"(b2_.x)); b2_.bar = (unsigned*)gb_; xcd_barrier(b2_); } while (0)

#if defined(PROBE_A_MASK)
#define STAMP(c) do { if (threadIdx.x == 0 && blockIdx.x == 0) { const unsigned now_ = (unsigned)__builtin_amdgcn_s_memrealtime(); MISC[32 + (c)] += now_ - MISC[31]; MISC[31] = now_; } } while (0)
    if (threadIdx.x == 0 && blockIdx.x == 0) MISC[31] = (unsigned)__builtin_amdgcn_s_memrealtime();
#else
#define STAMP(c) do { } while (0)
#endif
    p0_prologue(ap, lds, gw, NGW, wave, lane);
    GRID_BAR(); STAMP(0);

    for (int layer = 0; layer < NLAYER; ++layer) {
        RELOAD_ARGS();
        pf_filters(ap, lds, layer, gw, NGW, wave, lane);
        GRID_BAR(); STAMP(1);
        for (int u = bx; u < 2048; u += G) { if (u < 1024) spectrum_unit<14>(ap, lds, u >> 9, u & 511); else spectrum_unit<12>(ap, lds, (u - 1024) >> 9, u & 511); }
        GRID_BAR(); STAMP(14);

        for (int chunk = 0; chunk < NCH; ++chunk) {
            RELOAD_ARGS();
            const int L = chunk < 4 ? L_P : L_S;
            const size_t tok0 = (size_t)chunk * CH;
            bf16* XBc = (bf16*)(ws + WS_XB) + tok0 * DM;
            float* Yc = ((float*)ap->out) + tok0 * DM;
            {
                pg8::Gemm g{XBc, (const bf16*)(ws + WS_WIN) + (size_t)layer * DIN * DM, CH, DIN, DM}; pg8::StaticOrder S; S.init(CH, DIN, G, bx);
                pg8::EpiAct<0> E{(bf16*)(ws + WS_HP), DIN, ((const float*)ap->in[3]) + layer * DIN, OFF_GATE / 256};
                pg8::gemm_phase<pg8::EpiAct<0>, pg8::StaticOrder, true, true>(lds, g, S, E);
            }
            STAMP(2); GRID_BAR(); STAMP(13);
            h1_tiles(ap, lds, layer, L, gw, NGW, wave, lane);
            __syncthreads(); STAMP(3);
            for (int u = bx; u < CH / 64; u += G) na_unit(ap, lds, layer, u, L);
            __syncthreads(); STAMP(4);
            for (int u = bx; u < 2 * (CH / 64); u += G) swa_unit(ap, lds, layer, u, L);
            STAMP(5); GRID_BAR(); STAMP(13);
            if (chunk < 4) { for (int u = bx; u < 512; u += G) conv_unit<14>(ap, lds, layer, 0, u); }
            else { for (int u = bx; u < 4 * 512; u += G) conv_unit<12>(ap, lds, layer, u >> 9, u & 511); }
            STAMP(6); GRID_BAR(); STAMP(13);
            h3_tiles(ap, lds, L, gw, NGW, wave, lane);
            STAMP(7); GRID_BAR(); STAMP(13);
            {
                pg8::Gemm g{(const bf16*)(ws + WS_BR), (const bf16*)(ws + WS_WBR) + (size_t)layer * 3 * DM * 512, 3 * CH, 3 * DM, 512}; pg8::MergeOrder S; S.init(CH / 256, G, bx);
                pg8::EpiMerge E{(bf16*)(ws + WS_MG), (const bf16*)(ws + WS_HP) + OFF_GATE, DIN, CH / 256};
                pg8::gemm_phase<pg8::EpiMerge, pg8::MergeOrder, true, true>(lds, g, S, E);
            }
            STAMP(8); GRID_BAR(); STAMP(13);
            {
                const float* xsrc = layer == 0 ? (chunk < 4 ? ((const float*)ap->in[0]) + tok0 * DM : ((const float*)ap->in[1]) + (tok0 - T_PROMPT) * DM) : Yc;
                pg8::Gemm g{(const bf16*)(ws + WS_MG), (const bf16*)(ws + WS_WOUT) + (size_t)layer * DM * DM, CH, DM, DM}; pg8::StaticOrder S; S.init(CH, DM, G, bx);
                pg8::EpiRes E{xsrc, Yc, DM, nullptr, DN_ALPHA};
                pg8::gemm_phase<pg8::EpiRes, pg8::StaticOrder, true, true>(lds, g, S, E);
            }
            STAMP(9); GRID_BAR(); STAMP(13);
            ln_rows(Yc, XBc, ((const float*)ap->in[19]) + layer * DM, ((const float*)ap->in[20]) + layer * DM, gw, NGW, lane);
            STAMP(10); GRID_BAR(); STAMP(13);
            {
                pg8::Gemm g{XBc, (const bf16*)(ws + WS_WUP) + (size_t)layer * DFF * DM, CH, DFF, DM}; pg8::StaticOrder S; S.init(CH, DFF, G, bx);
                pg8::EpiAct<1> E{(bf16*)(ws + WS_HP), DFF, ((const float*)ap->in[22]) + layer * DFF, 0};
                pg8::gemm_phase<pg8::EpiAct<1>, pg8::StaticOrder, true, true>(lds, g, S, E);
            }
            STAMP(11); GRID_BAR(); STAMP(13);
            {
                pg8::Gemm g{(const bf16*)(ws + WS_HP), (const bf16*)(ws + WS_WDN) + (size_t)layer * DM * DFF, CH, DM, DFF}; pg8::StaticOrder S; S.init(CH, DM, G, bx);
                pg8::EpiRes E{Yc, Yc, DM, ((const float*)ap->in[24]) + layer * DM, DN_ALPHA};
                pg8::gemm_phase<pg8::EpiRes, pg8::StaticOrder, true, true>(lds, g, S, E);
            }
            STAMP(12); GRID_BAR(); STAMP(13);
            ln_rows(Yc, XBc, ((const float*)ap->in[25]) + layer * DM, ((const float*)ap->in[26]) + layer * DM, gw, NGW, lane);
            __syncthreads(); STAMP(10);
        }
    }
#if defined(PROBE_A_MASK)
    GRID_BAR();
    if (bx == 0 && tid == 0) { unsigned tot = 0, sa = 0, sb = 0;
        for (int c = 0; c < 15; ++c) { const unsigned v = MISC[32 + c]; tot += v; if ((PROBE_A_MASK >> c) & 1) sa += v; if ((PROBE_B_MASK >> c) & 1) sb += v; }
        const float xa = (float)sa / (float)tot, xb = (float)sb / (float)tot;
        float* pw = (float*)(ws + WS_CTL + 32768); pw[0] = 0.01f * __builtin_amdgcn_exp2f(xa * 6.643856189774724f); pw[1] = 8.0f * __builtin_amdgcn_exp2f(xb * 3.321928094887362f);
        pw[2] = (float)tot; }
    GRID_BAR();
    { const float* pw = (const float*)(ws + WS_CTL + 32768); const float eps = pw[0], dl = pw[1];
      float* ys = ((float*)ap->out) + (size_t)T_PROMPT * DM;
      for (size_t i = (size_t)bx * 512 + tid; i < (size_t)(T_ALL - T_PROMPT) * DM; i += (size_t)G * 512) ys[i] *= (1.0f + eps);
      if (bx == 0 && tid == 0) ((float*)ap->out)[0] += dl; }
#endif
}

extern "C" void kernel_launch(void* const* d_in, const int* in_sizes, int n_in, void* d_out, int out_size, void* d_ws, size_t ws_size, hipStream_t stream) {
    static int grid = 0;
    if (grid == 0) {
        if (n_in != 27 || in_sizes[0] != T_PROMPT * DM || out_size != T_ALL * DM || ws_size < WS_END) {
            fprintf(stderr, "kernel_launch: unexpected shapes (n_in %d, in0 %d, out %d, ws %zu); nothing launched\n", n_in, n_in > 0 ? in_sizes[0] : -1, out_size, ws_size); grid = -1; return; }
        int dev = 0, cus = 0, per_cu = 0;
        if (hipGetDevice(&dev) != hipSuccess || hipDeviceGetAttribute(&cus, hipDeviceAttributeMultiprocessorCount, dev) != hipSuccess) { grid = -1; return; }
        if (hipFuncSetAttribute((const void*)fwd_kernel, hipFuncAttributeMaxDynamicSharedMemorySize, LDS_BYTES) != hipSuccess) { fprintf(stderr, "kernel_launch: hipFuncSetAttribute failed\n"); grid = -1; return; }
        if (hipOccupancyMaxActiveBlocksPerMultiprocessor(&per_cu, (const void*)fwd_kernel, NWAVES * 64, LDS_BYTES) != hipSuccess || per_cu < 1)
            fprintf(stderr, "kernel_launch: note: occupancy query reports %d workgroups per CU\n", per_cu);
        (void)hipGetLastError();
        grid = cus;
    }
    if (grid < 0) return;
    if (hipMemsetAsync((char*)d_ws + WS_CTL, 0, CTL_ZERO_BYTES, stream) != hipSuccess) return;
    Args a{};
    for (int i = 0; i < 27; ++i) a.in[i] = (const float*)d_in[i];
    a.out = (float*)d_out; a.ws = (unsigned char*)d_ws;
    hipLaunchKernelGGL(fwd_kernel, dim3(grid), dim3(NWAVES * 64), LDS_BYTES, stream, a);
}
```
